# Optimizing an MI355X kernel written in HIP

```python
import jax, jax.numpy as jnp
from jax import lax
import numpy as np

D_MODEL = 1024
BATCH = 8
SEQ = 2048
DEPTH = 2

CHUNK = 64
Q_BLOCK = 128
N_A = DEPTH // 2
N_B = DEPTH - N_A
CONV_W = 3
N_HEADS = 8
QK_NOPE = 128
QK_ROPE = 64
V_HEAD = 128
Q_LORA = 384
KV_LORA = 256
D_FF = 2816
ROPE_THETA = 10000.0
EPS = 1e-6
NEG_INF = -1e30
MAX_POS_OFFSET = 8192

kernel_name = 'yoco_shortconv_mla_convffn'


def rms_norm(x, g):
    xf = x.astype(jnp.float32)
    y = xf * lax.rsqrt(jnp.mean(xf * xf, axis=-1, keepdims=True) + EPS)
    return (y * g.astype(jnp.float32)).astype(x.dtype)


def causal_dwconv(x, w):
    s = x.shape[1]
    xp = jnp.pad(x, ((0, 0), (CONV_W - 1, 0), (0, 0)))
    y = xp[:, 0:s, :] * w[0]
    for j in range(1, CONV_W):
        y = y + xp[:, j:j + s, :] * w[j]
    return y


def rope(x, positions):
    half = QK_ROPE // 2
    inv_freq = 1.0 / (ROPE_THETA ** (jnp.arange(half, dtype=jnp.float32) / half))
    ang = positions.astype(jnp.float32)[..., None] * inv_freq
    cos, sin = jnp.cos(ang), jnp.sin(ang)
    if x.ndim == 4:
        cos, sin = cos[:, :, None, :], sin[:, :, None, :]
    x1 = x[..., :half].astype(jnp.float32)
    x2 = x[..., half:].astype(jnp.float32)
    out = jnp.concatenate([x1 * cos - x2 * sin, x2 * cos + x1 * sin], axis=-1)
    return out.astype(x.dtype)


def short_conv_mixer(h, w_in, conv_w, w_out):
    b_gate, c_gate, u = jnp.split(h @ w_in, 3, axis=-1)
    return (b_gate * causal_dwconv(c_gate * u, conv_w)) @ w_out


def conv_ffn(h, w_up, conv_w, conv_b, w_down):
    g, v = jnp.split(h @ w_up, 2, axis=-1)
    g = causal_dwconv(g, conv_w) + conv_b
    return (jax.nn.silu(g) * v) @ w_down


def shared_kv(h, kv_in_norm, w_dkv, kv_latent_norm, w_kr, w_uk, w_uv, positions):
    b, s, _ = h.shape
    hn = rms_norm(h, kv_in_norm)
    c_kv = rms_norm(hn @ w_dkv, kv_latent_norm)
    k_rope = rope(hn @ w_kr, positions)
    k_nope = (c_kv @ w_uk).reshape(b, s, N_HEADS, QK_NOPE)
    v = (c_kv @ w_uv).reshape(b, s, N_HEADS, V_HEAD)
    return k_nope, k_rope, v


def mla_attention(h, w_dq, q_latent_norm, w_uq, w_o, k_nope, k_rope, v, positions):
    b, s, _ = h.shape
    c_q = rms_norm(h @ w_dq, q_latent_norm)
    q = (c_q @ w_uq).reshape(b, s, N_HEADS, QK_NOPE + QK_ROPE)
    q_nope = q[..., :QK_NOPE]
    q_rope = rope(q[..., QK_NOPE:], positions)
    scale = (QK_NOPE + QK_ROPE) ** -0.5
    nb = s // Q_BLOCK
    qn_blocks = q_nope.reshape(b, nb, Q_BLOCK, N_HEADS, QK_NOPE).transpose(1, 0, 2, 3, 4)
    qr_blocks = q_rope.reshape(b, nb, Q_BLOCK, N_HEADS, QK_ROPE).transpose(1, 0, 2, 3, 4)
    key_chunk = jnp.arange(s) // CHUNK

    def attend_block(args):
        qn, qr, blk = args
        sc = (jnp.einsum('bqhd,bkhd->bhqk', qn, k_nope)
              + jnp.einsum('bqhr,bkr->bhqk', qr, k_rope)).astype(jnp.float32) * scale
        q_chunk = (blk * Q_BLOCK + jnp.arange(Q_BLOCK)) // CHUNK
        mask = key_chunk[None, :] <= q_chunk[:, None]
        sc = jnp.where(mask[None, None], sc, NEG_INF)
        p = jax.nn.softmax(sc, axis=-1).astype(v.dtype)
        return jnp.einsum('bhqk,bkhd->bqhd', p, v)

    o = lax.map(attend_block, (qn_blocks, qr_blocks, jnp.arange(nb)))
    o = o.transpose(1, 0, 2, 3, 4).reshape(b, s, N_HEADS * V_HEAD)
    return o @ w_o


def setup_inputs(seed: int = 0) -> dict:
    key = jax.random.key(seed)
    ks = jax.random.split(key, 32)
    f32 = jnp.float32
    resid = (2 * DEPTH) ** -0.5

    def w(k, shape, fan_in, extra=1.0):
        return jax.random.normal(k, shape, f32) * (fan_in ** -0.5) * extra

    def gain(k, shape):
        return 1.0 + 0.02 * jax.random.normal(k, shape, f32)

    x = jax.random.normal(ks[0], (BATCH, SEQ, D_MODEL), f32)
    offsets = jax.random.randint(ks[1], (BATCH, 1), 0, MAX_POS_OFFSET, dtype=jnp.int32)
    positions = offsets + jnp.arange(SEQ, dtype=jnp.int32)[None, :]
    return {
        'x': x,
        'positions': positions,
        'attn_norm': gain(ks[2], (DEPTH, D_MODEL)),
        'ffn_norm': gain(ks[3], (DEPTH, D_MODEL)),
        'final_norm': gain(ks[4], (D_MODEL,)),
        'sc_w_in': w(ks[5], (N_A, D_MODEL, 3 * D_MODEL), D_MODEL),
        'sc_conv_w': w(ks[6], (N_A, CONV_W, D_MODEL), CONV_W),
        'sc_w_out': w(ks[7], (N_A, D_MODEL, D_MODEL), D_MODEL, resid),
        'kv_in_norm': gain(ks[8], (D_MODEL,)),
        'w_dkv': w(ks[9], (D_MODEL, KV_LORA), D_MODEL),
        'kv_latent_norm': gain(ks[10], (KV_LORA,)),
        'w_kr': w(ks[11], (D_MODEL, QK_ROPE), D_MODEL),
        'w_uk': w(ks[12], (KV_LORA, N_HEADS * QK_NOPE), KV_LORA),
        'w_uv': w(ks[13], (KV_LORA, N_HEADS * V_HEAD), KV_LORA),
        'w_dq': w(ks[14], (N_B, D_MODEL, Q_LORA), D_MODEL),
        'q_latent_norm': gain(ks[15], (N_B, Q_LORA)),
        'w_uq': w(ks[16], (N_B, Q_LORA, N_HEADS * (QK_NOPE + QK_ROPE)), Q_LORA),
        'w_o': w(ks[17], (N_B, N_HEADS * V_HEAD, D_MODEL), N_HEADS * V_HEAD, resid),
        'ffn_w_up': w(ks[18], (DEPTH, D_MODEL, 2 * D_FF), D_MODEL),
        'ffn_conv_w': w(ks[19], (DEPTH, CONV_W, D_FF), CONV_W),
        'ffn_conv_b': 0.02 * jax.random.normal(ks[20], (DEPTH, D_FF), f32),
        'ffn_w_down': w(ks[21], (DEPTH, D_FF, D_MODEL), D_FF, resid),
    }


def reference(x, positions, attn_norm, ffn_norm, final_norm, sc_w_in, sc_conv_w, sc_w_out,
              kv_in_norm, w_dkv, kv_latent_norm, w_kr, w_uk, w_uv,
              w_dq, q_latent_norm, w_uq, w_o,
              ffn_w_up, ffn_conv_w, ffn_conv_b, ffn_w_down):
    h = x
    kv = None
    for layer in range(DEPTH):
        hn = rms_norm(h, attn_norm[layer])
        if layer < N_A:
            h = h + short_conv_mixer(hn, sc_w_in[layer], sc_conv_w[layer], sc_w_out[layer])
        else:
            i = layer - N_A
            k_nope, k_rope, v = kv
            h = h + mla_attention(hn, w_dq[i], q_latent_norm[i], w_uq[i], w_o[i],
                                  k_nope, k_rope, v, positions)
        h = h + conv_ffn(rms_norm(h, ffn_norm[layer]), ffn_w_up[layer], ffn_conv_w[layer],
                         ffn_conv_b[layer], ffn_w_down[layer])
        if layer == N_A - 1:
            kv = shared_kv(h, kv_in_norm, w_dkv, kv_latent_norm, w_kr, w_uk, w_uv, positions)
    return rms_norm(h, final_norm)
```

```cpp
#include <hip/hip_runtime.h>
#include <hip/hip_cooperative_groups.h>
#include <cstdio>
#include <cstdint>
namespace pg8 {
#define PG8_LAS __attribute__((address_space(3)))
typedef unsigned short bf16_t;
typedef short bf16x8 __attribute__((ext_vector_type(8)));
typedef float f32x4 __attribute__((ext_vector_type(4)));
typedef unsigned u32x4 __attribute__((ext_vector_type(4)));
constexpr int BM = 256, BK = 64, HALF = 128, HTB = HALF * BK * 2  , STAGE_BYTES = 8 * HTB, NXCD = 8, WGM = 8;

__host__ __device__ __forceinline__ int lds_byte(int r, int c) { const int st = (r >> 4) * 2 + (c >> 5), rr = r & 15, cc = c & 31, ob = rr * 64 + cc * 2; return st * 1024 + (ob ^ (((ob >> 9) & 1) << 5)); }
__host__ __device__ __forceinline__ void stage_rc(int b, int& R, int& C) { const int st = b / 1024, sb = b % 1024, swz = sb ^ (((sb >> 9) & 1) << 5); R = (st >> 1) * 16 + swz / 64; C = (st & 1) * 32 + (swz % 64) / 2; }
__host__ __device__ __forceinline__ int perm32(int rho) { const int n = rho >> 4, i = rho & 15; return 8 * (i >> 2) + 4 * n + (i & 3); }

struct Unit { int pm, pn; };
struct Gemm { const bf16_t* A; const bf16_t* Bt; int M, N, K; };

struct StaticOrder {
    int nM, nN, nwg, G, c;
    __host__ __device__ void init(int M, int N, int G_, int c_) { nM = M / BM; nN = N / BM; nwg = nM * nN; G = G_; c = c_; }
    __host__ __device__ bool next(int i, Unit& u) const {
        const long L = (long)i * G + c; if (L >= nwg) return false;
        int wgid = (int)L; { const int q = nwg / NXCD, r = nwg % NXCD, xcd = wgid % NXCD, off = wgid / NXCD; wgid = (xcd < r ? xcd * (q + 1) : r * (q + 1) + (xcd - r) * q) + off; }
        const int nig = WGM * nN, gid = wgid / nig, fm = gid * WGM, gsz = (nM - fm) < WGM ? (nM - fm) : WGM;
        u.pm = fm + ((wgid % nig) % gsz); u.pn = (wgid % nig) / gsz; return true;
    }
    __device__ __forceinline__ void a_ready(const Unit&) const {}
    __device__ __forceinline__ void done(const Unit&) const {}
};
__device__ __forceinline__ unsigned cvt_pk_bf16(float lo, float hi) { unsigned r; asm volatile("v_cvt_pk_bf16_f32 %0, %1, %2" : "=v"(r) : "v"(lo), "v"(hi)); return r; }
typedef float f32x2 __attribute__((ext_vector_type(2)));
__device__ __forceinline__ float row_rstd(const float* ssq, int row) {
    const f32x4* p = (const f32x4*)(ssq + (size_t)row * 16);
    const f32x4 a = p[0], b = p[1], c = p[2], d = p[3];
    const f32x4 s = (a + b) + (c + d);
    return __builtin_amdgcn_rsqf(((s[0] + s[1]) + (s[2] + s[3])) * (1.0f / 1024.0f) + 1e-6f);
}
struct EpiBf16S {
    static constexpr bool PERM = true, AFTER_DRAIN = false;
    bf16_t* O0; bf16_t* O1; int split_cols; int ldc; const float* ssq;
    __device__ __forceinline__ void operator()(const f32x4 (&acc)[2][2][4][2], const Unit& u, int wr, int wc, int fr, int fq) const {
        const int row0 = u.pm * BM + wr * 64 + fr; int colt = u.pn * BM; bf16_t* base = O0;
        if (colt >= split_cols) { base = O1; colt -= split_cols; }
        const int col0 = colt + wc * 32 + 8 * fq;
#pragma unroll
        for (int ai = 0; ai < 2; ++ai)
#pragma unroll
            for (int m = 0; m < 4; ++m) { const int row = row0 + ai * HALF + m * 16; const float sc = ssq ? row_rstd(ssq, row) : 1.f;
                bf16_t* rowp = base + (size_t)row * ldc + col0;
#pragma unroll
                for (int bj = 0; bj < 2; ++bj) { const f32x4 v0 = acc[ai][bj][m][0] * sc, v1 = acc[ai][bj][m][1] * sc;
                    u32x4 w; w.x = cvt_pk_bf16(v0[0], v0[1]); w.y = cvt_pk_bf16(v0[2], v0[3]); w.z = cvt_pk_bf16(v1[0], v1[1]); w.w = cvt_pk_bf16(v1[2], v1[3]);
                    *(u32x4*)(rowp + bj * HALF) = w; } }
    }
};
struct EpiF32S {
    static constexpr bool PERM = false, AFTER_DRAIN = false;
    float* O; int ldc; const float* ssq;
    __device__ __forceinline__ void operator()(const f32x4 (&acc)[2][2][4][2], const Unit& u, int wr, int wc, int fr, int fq) const {
        const int row0 = u.pm * BM + wr * 64 + fr; const int col0 = u.pn * BM + wc * 32 + 4 * fq;
#pragma unroll
        for (int ai = 0; ai < 2; ++ai)
#pragma unroll
            for (int m = 0; m < 4; ++m) { const int row = row0 + ai * HALF + m * 16; const float sc = row_rstd(ssq, row);
                float* rowp = O + (size_t)row * ldc + col0;
#pragma unroll
                for (int bj = 0; bj < 2; ++bj)
#pragma unroll
                    for (int n = 0; n < 2; ++n) *(f32x4*)(rowp + bj * HALF + n * 16) = acc[ai][bj][m][n] * sc; }
    }
};
struct EpiRes {
    static constexpr bool PERM = false, AFTER_DRAIN = false;
    const float* base; float* out; bf16_t* hb; float* ssq; int ldc;
    __device__ __forceinline__ void operator()(const f32x4 (&acc)[2][2][4][2], const Unit& u, int wr, int wc, int fr, int fq) const {
        typedef unsigned u32x2v __attribute__((ext_vector_type(2)));
        const int row0 = u.pm * BM + wr * 64 + fr; const int col0 = u.pn * BM + wc * 32 + 4 * fq;
#pragma unroll
        for (int ai = 0; ai < 2; ++ai)
#pragma unroll
            for (int m = 0; m < 4; ++m) { const int row = row0 + ai * HALF + m * 16; const size_t off = (size_t)row * ldc + col0; float s = 0.f;
#pragma unroll
                for (int bj = 0; bj < 2; ++bj)
#pragma unroll
                    for (int n = 0; n < 2; ++n) { const f32x4 h = *(const f32x4*)(base + off + bj * HALF + n * 16) + acc[ai][bj][m][n];
                        *(f32x4*)(out + off + bj * HALF + n * 16) = h;
                        u32x2v w; w.x = cvt_pk_bf16(h[0], h[1]); w.y = cvt_pk_bf16(h[2], h[3]); *(u32x2v*)(hb + off + bj * HALF + n * 16) = w;
                        s += (h[0] * h[0] + h[1] * h[1]) + (h[2] * h[2] + h[3] * h[3]); }
                s += __shfl_xor(s, 16); s += __shfl_xor(s, 32);
                if (fq == 0) ssq[(size_t)row * 16 + u.pn * 4 + wc] = s;
                asm volatile("" ::: "memory"); }
    }
};
template <class Epi, class Sched, bool ALIGN_EPI = false, bool SP2 = false>
__device__ __forceinline__ void gemm_phase(PG8_LAS unsigned char* lds, const Gemm g, const Sched& S, const Epi& E) {
    int tid_ = threadIdx.x; asm volatile("" : "+v"(tid_));
    const int tid = tid_, wid = __builtin_amdgcn_readfirstlane(tid >> 6), lane = tid & 63, wr = wid >> 2, wc = wid & 3, fr = lane & 15, fq = lane >> 4;
    const int K = g.K, nt = K / BK;
    unsigned voffA[2], voffB[2];
#pragma unroll
    for (int i = 0; i < 2; ++i) { int R, C; stage_rc(tid * 16 + i * 8192, R, C); const int Rb = Epi::PERM ? ((R & ~31) + perm32(R & 31)) : R;
        voffA[i] = (unsigned)(R * K + C) * 2u; voffB[i] = (unsigned)(Rb * K + C) * 2u; }
    const size_t kstep = (size_t)(BK * 2);
    const size_t hstep = (size_t)HALF * K * 2;
    const size_t tstep = 2 * hstep;
    const unsigned ldsw = (unsigned)wid * 1024u;
    const int aoff = lds_byte(wr * 64 + fr, fq * 8), boff = lds_byte(wc * 32 + fr, fq * 8);
#define PG8_SA(b, h) (((b) * 2 + (h)) * HTB)
#define PG8_SB(b, h) ((4 + (b) * 2 + (h)) * HTB)
#define PG8_STAGE(bufoff, gbase, voff) do { _Pragma("unroll") for (int _i = 0; _i < 2; ++_i) \
        __builtin_amdgcn_global_load_lds((const unsigned*)((const char*)(gbase) + (voff)[_i]), (PG8_LAS unsigned*)(lds + (bufoff) + ldsw + _i * 8192), 16, 0, 0); } while (0)
#define PG8_LDA(dst, b, h) do { _Pragma("unroll") for (int m = 0; m < 4; ++m) _Pragma("unroll") for (int k = 0; k < 2; ++k) dst[m][k] = *(const PG8_LAS bf16x8*)(lds + PG8_SA(b, h) + aoff + m * 2048 + k * 1024); } while (0)
#define PG8_LDB(dst, b, h) do { _Pragma("unroll") for (int n = 0; n < 2; ++n) _Pragma("unroll") for (int k = 0; k < 2; ++k) dst[n][k] = *(const PG8_LAS bf16x8*)(lds + PG8_SB(b, h) + boff + n * 2048 + k * 1024); } while (0)
#define PG8_MMA(ai, bj, At, Bt) do { __builtin_amdgcn_s_setprio(1); _Pragma("unroll") for (int m = 0; m < 4; ++m) _Pragma("unroll") for (int n = 0; n < 2; ++n) _Pragma("unroll") for (int k = 0; k < 2; ++k) \
        acc[ai][bj][m][n] = __builtin_amdgcn_mfma_f32_16x16x32_bf16(Bt[n][k], At[m][k], acc[ai][bj][m][n], 0, 0, 0); __builtin_amdgcn_s_setprio(0); } while (0)
#define PG8_WAIT_V(n) asm volatile("s_waitcnt vmcnt(" #n ")" ::: "memory")
#define PG8_WAIT_L(n) asm volatile("s_waitcnt lgkmcnt(" #n ")" ::: "memory")
#define PG8_BAR __builtin_amdgcn_s_barrier()
#define PG8_SCHED __builtin_amdgcn_sched_barrier(0)
    Unit cur, nxt; int ui = 0;
    if (!S.next(0, cur)) return;
    f32x4 acc[2][2][4][2];
#pragma unroll
    for (int a = 0; a < 2; ++a)
#pragma unroll
        for (int b = 0; b < 2; ++b)
#pragma unroll
            for (int m = 0; m < 4; ++m)
#pragma unroll
                for (int n = 0; n < 2; ++n) acc[a][b][m][n] = (f32x4){0.f, 0.f, 0.f, 0.f};
    bf16x8 At[4][2], B0[2][2], B1[2][2];
    const char* cA = (const char*)g.A + (size_t)cur.pm * tstep; const char* cB = (const char*)g.Bt + (size_t)cur.pn * tstep;
    S.a_ready(cur);
    if constexpr (SP2) {
        PG8_STAGE(PG8_SB(0, 0), cB, voffB); PG8_STAGE(PG8_SB(0, 1), cB + hstep, voffB); PG8_STAGE(PG8_SA(0, 0), cA, voffA); PG8_STAGE(PG8_SA(0, 1), cA + hstep, voffA);
        if (wr == 1) PG8_BAR;
        PG8_WAIT_V(2); PG8_BAR;
        PG8_STAGE(PG8_SB(1, 0), cB + kstep, voffB); PG8_STAGE(PG8_SA(1, 0), cA + kstep, voffA); PG8_STAGE(PG8_SB(1, 1), cB + hstep + kstep, voffB);
        PG8_WAIT_V(6); PG8_BAR;
    } else {
        PG8_STAGE(PG8_SB(0, 0), cB, voffB); PG8_STAGE(PG8_SA(0, 0), cA, voffA); PG8_STAGE(PG8_SB(0, 1), cB + hstep, voffB); PG8_STAGE(PG8_SA(0, 1), cA + hstep, voffA);
        if (wr == 1) PG8_BAR;
        PG8_WAIT_V(4); PG8_BAR;
        PG8_STAGE(PG8_SB(1, 0), cB + kstep, voffB); PG8_STAGE(PG8_SA(1, 0), cA + kstep, voffA); PG8_STAGE(PG8_SB(1, 1), cB + hstep + kstep, voffB);
        PG8_WAIT_V(6); PG8_BAR;
    }
    for (;;) {
        const bool has_next = S.next(ui + 1, nxt);
        const char* nA = has_next ? (const char*)g.A + (size_t)nxt.pm * tstep : cA; const char* nB = has_next ? (const char*)g.Bt + (size_t)nxt.pn * tstep : cB;
        for (int t = 0; t < nt; t += 2) {
            const bool last = (t == nt - 2);
            const char* a1 = cA + (size_t)(t + 1) * kstep;
            const char* a2 = last ? nA : cA + (size_t)(t + 2) * kstep; const char* b2 = last ? nB : cB + (size_t)(t + 2) * kstep;
            const char* a3 = a2 + kstep; const char* b3 = b2 + kstep;
            if (last && has_next) S.a_ready(nxt);
            if constexpr (SP2) {
            PG8_LDB(B0, 0, 0); PG8_LDB(B1, 0, 1); PG8_SCHED; PG8_LDA(At, 0, 0); PG8_STAGE(PG8_SA(1, 1), a1 + hstep, voffA);
            PG8_WAIT_V(8); PG8_WAIT_L(0); PG8_BAR; PG8_MMA(0, 0, At, B0); PG8_MMA(0, 1, At, B1); PG8_BAR; PG8_SCHED;
            PG8_LDA(At, 0, 1); PG8_STAGE(PG8_SB(0, 0), b2, voffB); PG8_STAGE(PG8_SB(0, 1), b2 + hstep, voffB); PG8_STAGE(PG8_SA(0, 0), a2, voffA);
            PG8_WAIT_V(8); PG8_WAIT_L(0); PG8_BAR; PG8_MMA(1, 0, At, B0); PG8_MMA(1, 1, At, B1); PG8_BAR; PG8_SCHED;
            PG8_LDB(B0, 1, 0); PG8_LDB(B1, 1, 1); PG8_SCHED; PG8_LDA(At, 1, 0); PG8_STAGE(PG8_SA(0, 1), a2 + hstep, voffA);
            PG8_WAIT_V(8); PG8_WAIT_L(0); PG8_BAR; PG8_MMA(0, 0, At, B0); PG8_MMA(0, 1, At, B1); PG8_BAR; PG8_SCHED;
            PG8_LDA(At, 1, 1); PG8_STAGE(PG8_SB(1, 0), b3, voffB); PG8_STAGE(PG8_SB(1, 1), b3 + hstep, voffB); PG8_STAGE(PG8_SA(1, 0), a3, voffA);
            PG8_WAIT_V(8); PG8_WAIT_L(0); PG8_BAR; PG8_MMA(1, 0, At, B0); PG8_MMA(1, 1, At, B1); PG8_BAR; PG8_SCHED;
            } else {
            PG8_LDB(B0, 0, 0); PG8_SCHED; PG8_LDA(At, 0, 0); PG8_STAGE(PG8_SA(1, 1), a1 + hstep, voffA);
            PG8_WAIT_L(8); PG8_BAR; PG8_WAIT_L(0); PG8_MMA(0, 0, At, B0); PG8_BAR; PG8_SCHED;
            PG8_LDB(B1, 0, 1); PG8_STAGE(PG8_SB(0, 0), b2, voffB);
            PG8_BAR; PG8_WAIT_L(0); PG8_MMA(0, 1, At, B1); PG8_BAR;
            PG8_LDA(At, 0, 1); PG8_STAGE(PG8_SA(0, 0), a2, voffA);
            PG8_BAR; PG8_WAIT_L(0); PG8_MMA(1, 0, At, B0); PG8_BAR; PG8_SCHED;
            PG8_STAGE(PG8_SB(0, 1), b2 + hstep, voffB);
            PG8_WAIT_V(6); PG8_BAR; PG8_MMA(1, 1, At, B1); PG8_BAR;
            PG8_LDB(B0, 1, 0); PG8_SCHED; PG8_LDA(At, 1, 0); PG8_STAGE(PG8_SA(0, 1), a2 + hstep, voffA);
            PG8_WAIT_L(8); PG8_BAR; PG8_WAIT_L(0); PG8_MMA(0, 0, At, B0); PG8_BAR; PG8_SCHED;
            PG8_LDB(B1, 1, 1); PG8_STAGE(PG8_SB(1, 0), b3, voffB);
            PG8_BAR; PG8_WAIT_L(0); PG8_MMA(0, 1, At, B1); PG8_BAR;
            PG8_LDA(At, 1, 1); PG8_STAGE(PG8_SA(1, 0), a3, voffA);
            PG8_BAR; PG8_WAIT_L(0); PG8_MMA(1, 0, At, B0); PG8_BAR; PG8_SCHED;
            PG8_STAGE(PG8_SB(1, 1), b3 + hstep, voffB);
            PG8_WAIT_V(6); PG8_BAR; PG8_MMA(1, 1, At, B1); PG8_BAR;
            }
        }
        if constexpr (ALIGN_EPI) { if (wr == 0) PG8_BAR; }
        if constexpr (!Epi::AFTER_DRAIN) { E(acc, cur, wr, wc, fr, fq); S.done(cur); }
        if (!has_next) break;
#pragma unroll
        for (int a = 0; a < 2; ++a)
#pragma unroll
            for (int b = 0; b < 2; ++b)
#pragma unroll
                for (int m = 0; m < 4; ++m)
#pragma unroll
                    for (int n = 0; n < 2; ++n) acc[a][b][m][n] = (f32x4){0.f, 0.f, 0.f, 0.f};
        cur = nxt; cA = nA; cB = nB; ++ui;
        if constexpr (ALIGN_EPI) { if (wr == 1) PG8_BAR; }
    }
    PG8_WAIT_V(0);
    if constexpr (!ALIGN_EPI) { if (wr == 0) PG8_BAR; }
    PG8_BAR;
    if constexpr (Epi::AFTER_DRAIN) { E.fused(acc, cur, wr, wc, fr, fq, lds, wid, lane); S.done(cur); }
#undef PG8_SA
#undef PG8_SB
#undef PG8_STAGE
#undef PG8_LDA
#undef PG8_LDB
#undef PG8_MMA
#undef PG8_WAIT_V
#undef PG8_WAIT_L
#undef PG8_BAR
#undef PG8_SCHED
}
}

namespace att {
using bf16x8 = __attribute__((ext_vector_type(8))) short;
using s16x4  = __attribute__((ext_vector_type(4))) short;
using f32x16 = __attribute__((ext_vector_type(16))) float;
using f32x4  = __attribute__((ext_vector_type(4))) float;
using u32x4  = __attribute__((ext_vector_type(4))) unsigned;
constexpr float SCALE = 0.07216878364870322f;
constexpr float THR = 8.f;
constexpr int SHM_V = 64 * 128 * 2, SHM_KN = 64 * 128 * 2, SHM_KR = 64 * 64 * 2;
constexpr int OFF_V = 0, OFF_KN = 2 * SHM_V, OFF_KR = OFF_KN + 2 * SHM_KN, OFF_WS = OFF_KR + 2 * SHM_KR, LDS_BYTES = OFF_WS + 8 * 64 * 4;
#define KSWZ(row, colB) ((row) * 256 + ((colB) ^ (((row) & 7) << 4)))
#define KRSWZ(row, colB) ((row) * 128 + ((colB) ^ (((row) & 7) << 4)))
#define SBAR() __builtin_amdgcn_sched_barrier(0)
__device__ __forceinline__ int crow(int r, int hi) { return (r & 3) + 8 * (r >> 2) + 4 * hi; }
__device__ __forceinline__ unsigned cvtpk(float lo, float hi) { unsigned r; asm volatile("v_cvt_pk_bf16_f32 %0, %1, %2" : "=v"(r) : "v"(lo), "v"(hi)); return r; }
__device__ __forceinline__ float bf_lo(unsigned w) { return __uint_as_float(w << 16); }
__device__ __forceinline__ float bf_hi(unsigned w) { return __uint_as_float(w & 0xffff0000u); }

__device__ __forceinline__ void partialSM(f32x16& p0, f32x16& p1, float& m_reg, float& alpha) {
  constexpr float C = SCALE * 1.4426950408889634f;
  float pmax = p0[0];
#pragma unroll
  for (int r = 1; r < 16; ++r) pmax = fmaxf(pmax, p0[r]);
#pragma unroll
  for (int r = 0; r < 16; ++r) pmax = fmaxf(pmax, p1[r]);
  { auto rr = __builtin_amdgcn_permlane32_swap(__float_as_uint(pmax), __float_as_uint(pmax), false, false);
    pmax = fmaxf(__uint_as_float(rr[0]), __uint_as_float(rr[1])); }
  float mn;
  if (__builtin_expect(__all(pmax - m_reg <= THR / SCALE), 1)) { mn = m_reg; alpha = 1.f; }
  else { mn = fmaxf(m_reg, pmax); alpha = __builtin_amdgcn_exp2f((m_reg - mn) * C); m_reg = mn; }
  const float mnC = -mn * C;
#pragma unroll
  for (int r = 0; r < 16; ++r) p0[r] = __builtin_amdgcn_exp2f(fmaf(p0[r], C, mnC));
#pragma unroll
  for (int r = 0; r < 16; ++r) p1[r] = __builtin_amdgcn_exp2f(fmaf(p1[r], C, mnC));
}
__device__ __forceinline__ void finishSM(f32x16& p0, f32x16& p1, float alpha, float& l_reg, bf16x8& pa0, bf16x8& pa1, bf16x8& pa2, bf16x8& pa3) {
  float ps = 0;
#pragma unroll
  for (int r = 0; r < 16; ++r) ps += p0[r];
#pragma unroll
  for (int r = 0; r < 16; ++r) ps += p1[r];
  { auto rr = __builtin_amdgcn_permlane32_swap(__float_as_uint(ps), __float_as_uint(ps), false, false);
    ps = __uint_as_float(rr[0]) + __uint_as_float(rr[1]); }
  l_reg = l_reg * alpha + ps;
#define PK4(P, BASE, OUT) do { unsigned a0 = cvtpk(P[BASE + 0], P[BASE + 1]), a1 = cvtpk(P[BASE + 2], P[BASE + 3]);   \
    unsigned b0 = cvtpk(P[BASE + 4], P[BASE + 5]), b1 = cvtpk(P[BASE + 6], P[BASE + 7]);                              \
    auto r0 = __builtin_amdgcn_permlane32_swap(a0, b0, false, false); auto r1 = __builtin_amdgcn_permlane32_swap(a1, b1, false, false); \
    u32x4 w = {r0[0], r1[0], r0[1], r1[1]}; OUT = *reinterpret_cast<bf16x8*>(&w); } while (0)
  PK4(p0, 0, pa0); PK4(p0, 8, pa1); PK4(p1, 0, pa2); PK4(p1, 8, pa3);
#undef PK4
}
__device__ __forceinline__ void qkt(f32x16& p0, f32x16& p1, const char* Kn, const char* Kr, const bf16x8* qr, int r32, int hi) {
  p0 = f32x16{}; p1 = f32x16{};
#pragma unroll
  for (int d0 = 0; d0 < 8; ++d0) { const int cb = (d0 * 16 + hi * 8) * 2;
    const bf16x8 b0 = *reinterpret_cast<const bf16x8*>(Kn + KSWZ(r32, cb));
    const bf16x8 b1 = *reinterpret_cast<const bf16x8*>(Kn + KSWZ(32 + r32, cb));
    p0 = __builtin_amdgcn_mfma_f32_32x32x16_bf16(b0, qr[d0], p0, 0, 0, 0);
    p1 = __builtin_amdgcn_mfma_f32_32x32x16_bf16(b1, qr[d0], p1, 0, 0, 0); }
#pragma unroll
  for (int d0 = 0; d0 < 4; ++d0) { const int cb = (d0 * 16 + hi * 8) * 2;
    const bf16x8 b0 = *reinterpret_cast<const bf16x8*>(Kr + KRSWZ(r32, cb));
    const bf16x8 b1 = *reinterpret_cast<const bf16x8*>(Kr + KRSWZ(32 + r32, cb));
    p0 = __builtin_amdgcn_mfma_f32_32x32x16_bf16(b0, qr[8 + d0], p0, 0, 0, 0);
    p1 = __builtin_amdgcn_mfma_f32_32x32x16_bf16(b1, qr[8 + d0], p1, 0, 0, 0); }
}
__device__ __forceinline__ int v_st(int k, int c) { const int kk = (k & ~0xC) | ((k & 4) << 1) | ((k & 8) >> 1); return ((kk >> 3) * 4 + (c >> 5)) * 512 + ((kk & 7) * 32 + (c & 31)) * 2; }
__device__ __forceinline__ int v_rd_base(int lane) { return ((lane & 3) << 3) | (((lane >> 2) & 3) << 6) | (((lane >> 4) & 1) << 5) | (((lane >> 5) & 1) << 8); }
constexpr int v_rd_off(int d0, int ks, int half) { return d0 * 512 + ks * 4096 + half * 2048; }
template <int OFF> __device__ __forceinline__ s16x4 tr_read(int vb) {
  s16x4 r; asm volatile("ds_read_b64_tr_b16 %0, %1 offset:%2" : "=&v"(r) : "v"(vb), "i"(OFF) : "memory"); return r;
}
template <int D0> __device__ __forceinline__ void pv_one(f32x16& od, int vb, bf16x8 pa0, bf16x8 pa1, bf16x8 pa2, bf16x8 pa3) {
  const s16x4 l0 = tr_read<v_rd_off(D0, 0, 0)>(vb), h0 = tr_read<v_rd_off(D0, 0, 1)>(vb), l1 = tr_read<v_rd_off(D0, 1, 0)>(vb), h1 = tr_read<v_rd_off(D0, 1, 1)>(vb);
  const s16x4 l2 = tr_read<v_rd_off(D0, 2, 0)>(vb), h2 = tr_read<v_rd_off(D0, 2, 1)>(vb), l3 = tr_read<v_rd_off(D0, 3, 0)>(vb), h3 = tr_read<v_rd_off(D0, 3, 1)>(vb);
  asm volatile("s_waitcnt lgkmcnt(0)" ::: "memory"); SBAR();
#define PK(L, H) (bf16x8){L[0], L[1], L[2], L[3], H[0], H[1], H[2], H[3]}
  od = __builtin_amdgcn_mfma_f32_32x32x16_bf16(pa0, PK(l0, h0), od, 0, 0, 0);
  od = __builtin_amdgcn_mfma_f32_32x32x16_bf16(pa1, PK(l1, h1), od, 0, 0, 0);
  od = __builtin_amdgcn_mfma_f32_32x32x16_bf16(pa2, PK(l2, h2), od, 0, 0, 0);
  od = __builtin_amdgcn_mfma_f32_32x32x16_bf16(pa3, PK(l3, h3), od, 0, 0, 0);
#undef PK
}
__device__ __forceinline__ void pv_d0(f32x16* o, int vb, bf16x8 pa0, bf16x8 pa1, bf16x8 pa2, bf16x8 pa3) {
  pv_one<0>(o[0], vb, pa0, pa1, pa2, pa3); pv_one<1>(o[1], vb, pa0, pa1, pa2, pa3); pv_one<2>(o[2], vb, pa0, pa1, pa2, pa3); pv_one<3>(o[3], vb, pa0, pa1, pa2, pa3);
}
__device__ __forceinline__ void rope_pair(bf16x8& x1, bf16x8& x2, const float* cs, int i0) {
  const f32x4 c0 = *(const f32x4*)(cs + i0), c1 = *(const f32x4*)(cs + i0 + 4), s0 = *(const f32x4*)(cs + 32 + i0), s1 = *(const f32x4*)(cs + 32 + i0 + 4);
  const float c[8] = {c0[0], c0[1], c0[2], c0[3], c1[0], c1[1], c1[2], c1[3]}, s[8] = {s0[0], s0[1], s0[2], s0[3], s1[0], s1[1], s1[2], s1[3]};
  u32x4 a = *reinterpret_cast<u32x4*>(&x1), b = *reinterpret_cast<u32x4*>(&x2), oa, ob;
#pragma unroll
  for (int w = 0; w < 4; ++w) {
    const float a0 = bf_lo(a[w]), a1 = bf_hi(a[w]), b0 = bf_lo(b[w]), b1 = bf_hi(b[w]);
    oa[w] = cvtpk(a0 * c[2 * w] - b0 * s[2 * w], a1 * c[2 * w + 1] - b1 * s[2 * w + 1]);
    ob[w] = cvtpk(b0 * c[2 * w] + a0 * s[2 * w], b1 * c[2 * w + 1] + a1 * s[2 * w + 1]); }
  x1 = *reinterpret_cast<bf16x8*>(&oa); x2 = *reinterpret_cast<bf16x8*>(&ob);
}
__device__ __forceinline__ void attn_unit(const unsigned short* __restrict__ Q, const unsigned short* __restrict__ Kn, const unsigned short* __restrict__ Kr, const unsigned short* __restrict__ V,
                                          const float* __restrict__ cs, unsigned short* __restrict__ O, int b, int h, int qb, char* lds) {
  int tid_ = threadIdx.x; asm volatile("" : "+v"(tid_));
  const int tid = tid_, wid = __builtin_amdgcn_readfirstlane(tid >> 6), lane = tid & 63, r32 = lane & 31, hi = lane >> 5;
  const long rowbase = (long)b * 2048; const int q0 = qb * 256;
  char* V_lds = lds + OFF_V; char* Kn_lds = lds + OFF_KN; char* Kr_lds = lds + OFF_KR;
  float* ws = (float*)(lds + OFF_WS) + wid * 64; float* li_l = ws; float* al_l = ws + 32;
  float m_reg = -1e30f, l_reg = 0; f32x16 o[4] = {}; bf16x8 qr[12];
  const long qrow = rowbase + q0 + wid * 32 + r32;
  const unsigned short* Qw = Q + qrow * 1536 + h * 192 + hi * 8;
#pragma unroll
  for (int d0 = 0; d0 < 12; ++d0) qr[d0] = *reinterpret_cast<const bf16x8*>(Qw + d0 * 16);
  rope_pair(qr[8], qr[10], cs + qrow * 64, hi * 8);
  rope_pair(qr[9], qr[11], cs + qrow * 64, 16 + hi * 8);
  const int sr = tid >> 4, sc = (tid & 15) * 8, vst0 = v_st(sr, sc), vst1 = v_st(32 + sr, sc);
  const int rr_ = tid >> 3, rc_ = (tid & 7) * 8;
  const int vb0 = (int)(uintptr_t)V_lds + v_rd_base(lane);
  const unsigned short* Knh = Kn + rowbase * 1024 + h * 128; const unsigned short* Vh = V + rowbase * 1024 + h * 128; const unsigned short* Krb = Kr + rowbase * 64;
  bf16x8 vs0, vs1, ks0, ks1, kr0;
#define SLOAD(k0) do { vs0 = *reinterpret_cast<const bf16x8*>(&Vh[(long)((k0) + sr) * 1024 + sc]); vs1 = *reinterpret_cast<const bf16x8*>(&Vh[(long)((k0) + 32 + sr) * 1024 + sc]); \
    ks0 = *reinterpret_cast<const bf16x8*>(&Knh[(long)((k0) + sr) * 1024 + sc]); ks1 = *reinterpret_cast<const bf16x8*>(&Knh[(long)((k0) + 32 + sr) * 1024 + sc]); \
    kr0 = *reinterpret_cast<const bf16x8*>(&Krb[(long)((k0) + rr_) * 64 + rc_]); } while (0)
#define SWRITE(bb) do { *(bf16x8*)(V_lds + (bb) * SHM_V + vst0) = vs0; *(bf16x8*)(V_lds + (bb) * SHM_V + vst1) = vs1; \
    *(bf16x8*)(Kn_lds + (bb) * SHM_KN + KSWZ(sr, sc * 2)) = ks0; *(bf16x8*)(Kn_lds + (bb) * SHM_KN + KSWZ(32 + sr, sc * 2)) = ks1; \
    *(bf16x8*)(Kr_lds + (bb) * SHM_KR + KRSWZ(rr_, rc_ * 2)) = kr0; } while (0)
  const int NT = 4 * (qb + 1);
  const int myNT = 4 * qb + (wid >> 1) + 1;
  SLOAD(0); SWRITE(0);
  for (int j = 0; j < NT; ++j) {
    __syncthreads();
    if (j + 1 < NT) SLOAD((j + 1) * 64);
    if (j < myNT) {
      f32x16 p0, p1; float alpha; bf16x8 pa0, pa1, pa2, pa3;
      qkt(p0, p1, Kn_lds + (j & 1) * SHM_KN, Kr_lds + (j & 1) * SHM_KR, qr, r32, hi);
      partialSM(p0, p1, m_reg, alpha);
      if (__any(alpha < 1.f)) { if (hi == 0) al_l[r32] = alpha; asm volatile("s_waitcnt lgkmcnt(0)" ::: "memory");
#pragma unroll
        for (int d = 0; d < 4; ++d)
#pragma unroll
          for (int r = 0; r < 16; ++r) o[d][r] *= al_l[crow(r, hi)]; }
      finishSM(p0, p1, alpha, l_reg, pa0, pa1, pa2, pa3); SBAR();
      pv_d0(o, vb0 + (j & 1) * SHM_V, pa0, pa1, pa2, pa3);
    }
    if (j + 1 < NT) SWRITE((j + 1) & 1);
  }
  if (hi == 0) li_l[r32] = l_reg; asm volatile("s_waitcnt lgkmcnt(0)" ::: "memory");
  float rli[16];
#pragma unroll
  for (int r = 0; r < 16; ++r) rli[r] = __builtin_amdgcn_rcpf(li_l[crow(r, hi)]);
  unsigned short* Ow = O + (rowbase + q0 + wid * 32) * 1024 + h * 128;
#pragma unroll
  for (int r = 0; r < 16; ++r) { const int orow = crow(r, hi);
#pragma unroll
    for (int d0 = 0; d0 < 4; ++d0) { const unsigned w = cvtpk(o[d0][r] * rli[r], 0.f); Ow[(long)orow * 1024 + d0 * 32 + r32] = (unsigned short)(w & 0xffffu); } }
  __syncthreads();
#undef SLOAD
#undef SWRITE
}
#undef SBAR
}

namespace cg = cooperative_groups;
#define LAS __attribute__((address_space(3)))
typedef unsigned short bf16;
typedef float f32x4 __attribute__((ext_vector_type(4)));
typedef float f32x2 __attribute__((ext_vector_type(2)));
typedef unsigned v4u __attribute__((ext_vector_type(4)));
typedef unsigned v2u __attribute__((ext_vector_type(2)));
constexpr int NWAVES = 8, NTHR = 512;
constexpr int M = 16384, D = 1024, SEQ = 2048, DFF = 2816, NUP = 2 * DFF, NSC = 3 * D, NCOMB = 768, NKV = 2048, NQ = 1536, KVL = 256, QL = 384;
constexpr size_t MiB = 1u << 20;
constexpr size_t WS_SSQ = 0;
constexpr size_t WS_CS = 1 * MiB;
constexpr size_t WS_WIN = 5 * MiB;
constexpr size_t WS_WOUT = 11 * MiB;
constexpr size_t WS_WUP = 13 * MiB;
constexpr size_t WS_WDN = 24 * MiB;
constexpr size_t WS_WCOMB = 30 * MiB;
constexpr size_t WS_WUKV = 32 * MiB;
constexpr size_t WS_WUQ = 33 * MiB;
constexpr size_t WS_WO = 35 * MiB;
constexpr size_t WS_HB = 37 * MiB;
constexpr size_t WS_BIG = 69 * MiB;
constexpr size_t WS_END = WS_BIG + 176 * MiB;
constexpr size_t HB_CKV = WS_HB, HB_CQ = WS_HB + 8 * MiB, HB_KR = WS_HB + 20 * MiB;
constexpr size_t BIG_G = WS_BIG, BIG_V = WS_BIG + 88 * MiB;
constexpr size_t BIG_SC = WS_BIG, BIG_MIX = WS_BIG + 96 * MiB;
constexpr size_t BIG_COMB = WS_BIG, BIG_O = WS_BIG, BIG_Q = WS_BIG + 48 * MiB, BIG_KN = WS_BIG + 96 * MiB, BIG_VV = WS_BIG + 128 * MiB;
constexpr int LDS_BYTES = 131072;

struct Args { const float* in[22]; const int* pos; float* out; unsigned char* ws; };

__device__ __forceinline__ unsigned f2bf(float f) { unsigned u = __builtin_bit_cast(unsigned, f); return (u + 0x7fffu + ((u >> 16) & 1u)) >> 16; }
__device__ __forceinline__ unsigned pk2(float lo, float hi) { return f2bf(lo) | (f2bf(hi) << 16); }
__device__ __forceinline__ float bflo(unsigned w) { return __uint_as_float(w << 16); }
__device__ __forceinline__ float bfhi(unsigned w) { return __uint_as_float(w & 0xffff0000u); }
__device__ __forceinline__ float wave_sum(float v) {
#pragma unroll
    for (int o = 1; o < 64; o <<= 1) v += __shfl_xor(v, o);
    return v;
}
__device__ __forceinline__ void transpose_item(const float* W, int K, int N, bf16* WT, int row_off, const float* gain, LAS float* scr, int item, int lane) {
    const int nblk = N / 32, kb = item / nblk, nb = item % nblk, k0 = 64 * kb, n0 = 32 * nb;
#pragma unroll 8
    for (int i = 0; i < 32; ++i) { const int kk = 2 * i + (lane >> 5); const float g = gain ? gain[k0 + kk] : 1.f; scr[kk * 33 + (lane & 31)] = W[(size_t)(k0 + kk) * N + n0 + (lane & 31)] * g; }
    asm volatile("s_waitcnt lgkmcnt(0)" ::: "memory");
    const int c = lane & 7;
#pragma unroll
    for (int j = 0; j < 4; ++j) { const int n = (lane >> 3) + 8 * j; const LAS float* s = scr + (8 * c) * 33 + n;
        v4u o; o.x = pk2(s[0 * 33], s[1 * 33]); o.y = pk2(s[2 * 33], s[3 * 33]); o.z = pk2(s[4 * 33], s[5 * 33]); o.w = pk2(s[6 * 33], s[7 * 33]);
        *(v4u*)(WT + (size_t)(row_off + n0 + n) * K + k0 + 8 * c) = o; }
    asm volatile("s_waitcnt lgkmcnt(0)" ::: "memory");
}
struct TJob { const float* W; int K, N; bf16* WT; int row_off; const float* gain; };
__device__ __forceinline__ int tjob_items(const TJob& j) { return (j.K / 64) * (j.N / 32); }

__device__ __forceinline__ void sincos_red(double r, float& sn, float& cs_) {
    const double y = 0.5 * r, y2 = y * y;
    double s = -7.6471637318198164759e-13;
    s = s * y2 + 1.6059043836821614599e-10;
    s = s * y2 - 2.5052108385441718775e-8;
    s = s * y2 + 2.7557319223985890653e-6;
    s = s * y2 - 1.9841269841269841270e-4;
    s = s * y2 + 8.3333333333333333333e-3;
    s = s * y2 - 1.6666666666666666667e-1;
    s = s * y2 + 1.0; s *= y;
    double c = 4.7794773323873852974e-14;
    c = c * y2 - 1.1470745597729724714e-11;
    c = c * y2 + 2.0876756987868098979e-9;
    c = c * y2 - 2.7557319223985890653e-7;
    c = c * y2 + 2.4801587301587301587e-5;
    c = c * y2 - 1.3888888888888888889e-3;
    c = c * y2 + 4.1666666666666666667e-2;
    c = c * y2 - 0.5;
    c = c * y2 + 1.0;
    sn = (float)(2.0 * s * c); cs_ = (float)(1.0 - 2.0 * s * s);
}

__global__ void __launch_bounds__(NTHR) fwd_megakernel(Args args) {
    extern __shared__ __attribute__((aligned(16))) unsigned char lds[];
    cg::grid_group grid = cg::this_grid();
    const int G = gridDim.x, bx = blockIdx.x;
#define PHASE_IDS int tid_ = threadIdx.x; asm volatile("" : "+v"(tid_)); const int tid = tid_, lane = tid & 63, wave = __builtin_amdgcn_readfirstlane(tid >> 6); \
    const int vcu = (G % 8 == 0) ? (bx % 8) * (G / 8) + bx / 8 : bx; const int gw = vcu * NWAVES + wave, NGW = G * NWAVES; const int gt = bx * NTHR + tid, NGT = G * NTHR; \
    (void)lane; (void)gw; (void)NGW; (void)gt; (void)NGT; (void)vcu;
    unsigned char* ws = args.ws;
    LAS unsigned char* ldsl = (LAS unsigned char*)lds;
    const float* x = args.in[0];
    const float *attn_norm = args.in[2], *ffn_norm = args.in[3], *final_norm = args.in[4], *sc_w_in = args.in[5], *sc_conv_w = args.in[6], *sc_w_out = args.in[7];
    const float *kv_in_norm = args.in[8], *w_dkv = args.in[9], *kv_latent_norm = args.in[10], *w_kr = args.in[11], *w_uk = args.in[12], *w_uv = args.in[13];
    const float *w_dq = args.in[14], *q_latent_norm = args.in[15], *w_uq = args.in[16], *w_o = args.in[17];
    const float *ffn_w_up = args.in[18], *ffn_conv_w = args.in[19], *ffn_conv_b = args.in[20], *ffn_w_down = args.in[21];
    float* out = args.out;
    float* ssq = (float*)(ws + WS_SSQ); float* cst = (float*)(ws + WS_CS);
    bf16 *Win = (bf16*)(ws + WS_WIN), *Wout = (bf16*)(ws + WS_WOUT), *Wup = (bf16*)(ws + WS_WUP), *Wdn = (bf16*)(ws + WS_WDN), *Wcomb = (bf16*)(ws + WS_WCOMB),
         *Wukv = (bf16*)(ws + WS_WUKV), *Wuq = (bf16*)(ws + WS_WUQ), *Wo = (bf16*)(ws + WS_WO), *hb = (bf16*)(ws + WS_HB);

    {
        PHASE_IDS
        LAS float* scr = (LAS float*)(ldsl + wave * 16384);
        int base = 0;
#define TJ(W_, K_, N_, WT_, RO_, G_) { const int n_ = ((K_) / 64) * ((N_) / 32); int it = gw; if (it < base) it += ((base - it + NGW - 1) / NGW) * NGW; \
            for (; it < base + n_; it += NGW) transpose_item(W_, K_, N_, WT_, RO_, G_, scr, it - base, lane); base += n_; }
        TJ(sc_w_in, D, NSC, Win, 0, attn_norm) TJ(sc_w_out, D, D, Wout, 0, nullptr) TJ(ffn_w_up, D, NUP, Wup, 0, ffn_norm) TJ(ffn_w_down, DFF, D, Wdn, 0, nullptr)
        TJ(w_dkv, D, KVL, Wcomb, 0, kv_in_norm) TJ(w_kr, D, 64, Wcomb, 256, kv_in_norm) TJ(w_dq, D, QL, Wcomb, 320, attn_norm + D)
        TJ(w_uk, KVL, D, Wukv, 0, nullptr) TJ(w_uv, KVL, D, Wukv, 1024, nullptr) TJ(w_uq, QL, NQ, Wuq, 0, nullptr) TJ(w_o, D, D, Wo, 0, nullptr)
        for (int i = gt; i < 64 * D / 8; i += NGT) *(v4u*)(Wcomb + (size_t)704 * D + (size_t)i * 8) = (v4u){0u, 0u, 0u, 0u};
        for (int m = gw; m < M; m += NGW) {
            const f32x4* xr = (const f32x4*)(x + (size_t)m * D) + lane; unsigned long long* o8 = (unsigned long long*)(hb + (size_t)m * D) + lane; float s = 0.f;
#pragma unroll
            for (int j = 0; j < 4; ++j) { const f32x4 v = xr[64 * j]; s += (v[0] * v[0] + v[1] * v[1]) + (v[2] * v[2] + v[3] * v[3]);
                o8[64 * j] = (unsigned long long)pk2(v[0], v[1]) | ((unsigned long long)pk2(v[2], v[3]) << 32); }
            s = wave_sum(s);
            if (lane < 16) ssq[(size_t)m * 16 + lane] = lane == 0 ? s : 0.f;
        }
        for (int i = gt; i < M * 32; i += NGT) { const int row = i >> 5, f = i & 31;
            double inv = 1.0; for (int k = 0; k < f; ++k) inv *= 0.74989420933245582730;
            const double ang = (double)args.pos[row] * inv;
            const double kq = __builtin_rint(ang * 0.15915494309189535);
            double r = ang - kq * 6.283185307179586; r -= kq * 2.4492935982947064e-16;
            float sn, cs_; sincos_red(r, sn, cs_);
            cst[(size_t)row * 64 + f] = cs_; cst[(size_t)row * 64 + 32 + f] = sn; }
    }
    grid.sync();

#pragma nounroll
    for (int layer = 0; layer < 2; ++layer) {
        if (layer == 0) {
            { pg8::Gemm g{hb, Win, M, NSC, D}; pg8::StaticOrder S; S.init(M, NSC, G, bx);
              pg8::EpiBf16S E{(bf16*)(ws + BIG_SC), nullptr, 1 << 30, NSC, ssq};
              pg8::gemm_phase<pg8::EpiBf16S, pg8::StaticOrder, true, true>(ldsl, g, S, E); }
            grid.sync();
            { PHASE_IDS const bf16* sc = (const bf16*)(ws + BIG_SC); bf16* mix = (bf16*)(ws + BIG_MIX);
              for (int it = gt; it < (M / 16) * (D / 8); it += NGT) { const int tb = it / (D / 8), cgp = it % (D / 8), t0 = tb * 16, c0 = cgp * 8;
                float w0[8], w1[8], w2[8], p1[8], p2[8];
#pragma unroll
                for (int e = 0; e < 8; ++e) { w0[e] = sc_conv_w[c0 + e]; w1[e] = sc_conv_w[D + c0 + e]; w2[e] = sc_conv_w[2 * D + c0 + e]; p1[e] = 0.f; p2[e] = 0.f; }
                if (t0 % SEQ != 0) {
                    const v4u c2 = *(const v4u*)(sc + (size_t)(t0 - 2) * NSC + D + c0), u2 = *(const v4u*)(sc + (size_t)(t0 - 2) * NSC + 2 * D + c0);
                    const v4u c1 = *(const v4u*)(sc + (size_t)(t0 - 1) * NSC + D + c0), u1 = *(const v4u*)(sc + (size_t)(t0 - 1) * NSC + 2 * D + c0);
#pragma unroll
                    for (int w = 0; w < 4; ++w) { p2[2 * w] = bflo(c2[w]) * bflo(u2[w]); p2[2 * w + 1] = bfhi(c2[w]) * bfhi(u2[w]); p1[2 * w] = bflo(c1[w]) * bflo(u1[w]); p1[2 * w + 1] = bfhi(c1[w]) * bfhi(u1[w]); }
                }
#pragma unroll 4
                for (int t = 0; t < 16; ++t) { const size_t ro = (size_t)(t0 + t) * NSC + c0;
                    const v4u bb = *(const v4u*)(sc + ro), cc = *(const v4u*)(sc + ro + D), uu = *(const v4u*)(sc + ro + 2 * D); float cu[8], y[8];
#pragma unroll
                    for (int w = 0; w < 4; ++w) { cu[2 * w] = bflo(cc[w]) * bflo(uu[w]); cu[2 * w + 1] = bfhi(cc[w]) * bfhi(uu[w]); }
#pragma unroll
                    for (int e = 0; e < 8; ++e) { y[e] = w0[e] * p2[e] + w1[e] * p1[e] + w2[e] * cu[e]; p2[e] = p1[e]; p1[e] = cu[e]; }
                    v4u o;
#pragma unroll
                    for (int w = 0; w < 4; ++w) o[w] = pk2(bflo(bb[w]) * y[2 * w], bfhi(bb[w]) * y[2 * w + 1]);
                    *(v4u*)(mix + (size_t)(t0 + t) * D + c0) = o; } } }
            grid.sync();
            { pg8::Gemm g{(const bf16*)(ws + BIG_MIX), Wout, M, D, D}; pg8::StaticOrder S; S.init(M, D, G, bx);
              pg8::EpiRes E{x, out, hb, ssq, D};
              pg8::gemm_phase<pg8::EpiRes, pg8::StaticOrder, true, true>(ldsl, g, S, E); }
            grid.sync();
        } else {
            { pg8::Gemm g{hb, Wcomb, M, NCOMB, D}; pg8::StaticOrder S; S.init(M, NCOMB, G, bx);
              pg8::EpiF32S E{(float*)(ws + BIG_COMB), NCOMB, ssq};
              pg8::gemm_phase<pg8::EpiF32S, pg8::StaticOrder, true, true>(ldsl, g, S, E); }
            grid.sync();
            { PHASE_IDS const float* comb = (const float*)(ws + BIG_COMB); bf16* ckv = (bf16*)(ws + HB_CKV); bf16* cq = (bf16*)(ws + HB_CQ); bf16* kr = (bf16*)(ws + HB_KR);
              for (int m = gw; m < M; m += NGW) { const float* row = comb + (size_t)m * NCOMB;
                { const f32x4 v = *((const f32x4*)row + lane); const float s = wave_sum((v[0] * v[0] + v[1] * v[1]) + (v[2] * v[2] + v[3] * v[3]));
                  const float r = __builtin_amdgcn_rsqf(s * (1.f / KVL) + 1e-6f); const f32x4 gn = *((const f32x4*)kv_latent_norm + lane);
                  v2u o; o.x = pk2(v[0] * r * gn[0], v[1] * r * gn[1]); o.y = pk2(v[2] * r * gn[2], v[3] * r * gn[3]); *((v2u*)(ckv + (size_t)m * KVL) + lane) = o; }
                { const int i = lane & 31; const float x1 = row[256 + i], x2 = row[288 + i], c = cst[(size_t)m * 64 + i], s = cst[(size_t)m * 64 + 32 + i];
                  const float o = lane < 32 ? x1 * c - x2 * s : x2 * c + x1 * s; kr[(size_t)m * 64 + lane] = (bf16)f2bf(o); }
                { f32x2 v[3]; float s = 0.f;
#pragma unroll
                  for (int j = 0; j < 3; ++j) { v[j] = *((const f32x2*)(row + 320 + j * 128) + lane); s += v[j][0] * v[j][0] + v[j][1] * v[j][1]; }
                  s = wave_sum(s); const float r = __builtin_amdgcn_rsqf(s * (1.f / QL) + 1e-6f);
#pragma unroll
                  for (int j = 0; j < 3; ++j) { const f32x2 gn = *((const f32x2*)(q_latent_norm + j * 128) + lane);
                    *((unsigned*)(cq + (size_t)m * QL + j * 128) + lane) = pk2(v[j][0] * r * gn[0], v[j][1] * r * gn[1]); } } }
              LAS float* scr = (LAS float*)(ldsl + wave * 16384);
              const TJob j0{ffn_w_up + (size_t)D * NUP, D, NUP, Wup, 0, ffn_norm + D}, j1{ffn_w_down + (size_t)DFF * D, DFF, D, Wdn, 0, nullptr};
              const int n0 = tjob_items(j0), n1 = tjob_items(j1);
              for (int it = gw; it < n0 + n1; it += NGW) { if (it < n0) transpose_item(j0.W, j0.K, j0.N, j0.WT, 0, j0.gain, scr, it, lane); else transpose_item(j1.W, j1.K, j1.N, j1.WT, 0, nullptr, scr, it - n0, lane); } }
            grid.sync();
            { pg8::Gemm g{(const bf16*)(ws + HB_CKV), Wukv, M, NKV, KVL}; pg8::StaticOrder S; S.init(M, NKV, G, bx);
              pg8::EpiBf16S E{(bf16*)(ws + BIG_KN), (bf16*)(ws + BIG_VV), 1024, 1024, nullptr};
              pg8::gemm_phase<pg8::EpiBf16S, pg8::StaticOrder, true, true>(ldsl, g, S, E); }
            { pg8::Gemm g{(const bf16*)(ws + HB_CQ), Wuq, M, NQ, QL}; pg8::StaticOrder S; S.init(M, NQ, G, bx);
              pg8::EpiBf16S E{(bf16*)(ws + BIG_Q), nullptr, 1 << 30, NQ, nullptr};
              pg8::gemm_phase<pg8::EpiBf16S, pg8::StaticOrder, true, true>(ldsl, g, S, E); }
            grid.sync();
            { PHASE_IDS for (int p = vcu; p < 256; p += G) { const int bh = p >> 2, s4 = p & 3;
                att::attn_unit((const bf16*)(ws + BIG_Q), (const bf16*)(ws + BIG_KN), (const bf16*)(ws + HB_KR), (const bf16*)(ws + BIG_VV), cst, (bf16*)(ws + BIG_O), bh >> 3, bh & 7, 7 - s4, (char*)lds);
                att::attn_unit((const bf16*)(ws + BIG_Q), (const bf16*)(ws + BIG_KN), (const bf16*)(ws + HB_KR), (const bf16*)(ws + BIG_VV), cst, (bf16*)(ws + BIG_O), bh >> 3, bh & 7, s4, (char*)lds); } }
            grid.sync();
            { pg8::Gemm g{(const bf16*)(ws + BIG_O), Wo, M, D, D}; pg8::StaticOrder S; S.init(M, D, G, bx);
              pg8::EpiRes E{out, out, hb, ssq, D};
              pg8::gemm_phase<pg8::EpiRes, pg8::StaticOrder, true, true>(ldsl, g, S, E); }
            grid.sync();
        }
        { pg8::Gemm g{hb, Wup, M, NUP, D}; pg8::StaticOrder S; S.init(M, NUP, G, bx);
          pg8::EpiBf16S E{(bf16*)(ws + BIG_G), (bf16*)(ws + BIG_V), DFF, DFF, ssq};
          pg8::gemm_phase<pg8::EpiBf16S, pg8::StaticOrder, true, true>(ldsl, g, S, E); }
        grid.sync();
        { PHASE_IDS const bf16* gg = (const bf16*)(ws + BIG_G); bf16* vv = (bf16*)(ws + BIG_V); const float* cw = ffn_conv_w + (size_t)layer * 3 * DFF; const float* cb = ffn_conv_b + (size_t)layer * DFF;
          for (int it = gt; it < (M / 16) * (DFF / 8); it += NGT) { const int tb = it / (DFF / 8), cgp = it % (DFF / 8), t0 = tb * 16, c0 = cgp * 8;
            float w0[8], w1[8], w2[8], bs[8], p1[8], p2[8];
#pragma unroll
            for (int e = 0; e < 8; ++e) { w0[e] = cw[c0 + e]; w1[e] = cw[DFF + c0 + e]; w2[e] = cw[2 * DFF + c0 + e]; bs[e] = cb[c0 + e]; p1[e] = 0.f; p2[e] = 0.f; }
            if (t0 % SEQ != 0) { const v4u g2 = *(const v4u*)(gg + (size_t)(t0 - 2) * DFF + c0), g1 = *(const v4u*)(gg + (size_t)(t0 - 1) * DFF + c0);
#pragma unroll
                for (int w = 0; w < 4; ++w) { p2[2 * w] = bflo(g2[w]); p2[2 * w + 1] = bfhi(g2[w]); p1[2 * w] = bflo(g1[w]); p1[2 * w + 1] = bfhi(g1[w]); } }
#pragma unroll 4
            for (int t = 0; t < 16; ++t) { const size_t ro = (size_t)(t0 + t) * DFF + c0; const v4u g0 = *(const v4u*)(gg + ro), v0 = *(const v4u*)(vv + ro); float cu[8], y[8];
#pragma unroll
                for (int w = 0; w < 4; ++w) { cu[2 * w] = bflo(g0[w]); cu[2 * w + 1] = bfhi(g0[w]); }
#pragma unroll
                for (int e = 0; e < 8; ++e) { const float z = w0[e] * p2[e] + w1[e] * p1[e] + w2[e] * cu[e] + bs[e]; p2[e] = p1[e]; p1[e] = cu[e];
                    y[e] = z * __builtin_amdgcn_rcpf(1.f + __expf(-z)); }
                v4u o;
#pragma unroll
                for (int w = 0; w < 4; ++w) o[w] = pk2(y[2 * w] * bflo(v0[w]), y[2 * w + 1] * bfhi(v0[w]));
                *(v4u*)(vv + ro) = o; } } }
        grid.sync();
        { pg8::Gemm g{(const bf16*)(ws + BIG_V), Wdn, M, D, DFF}; pg8::StaticOrder S; S.init(M, D, G, bx);
          pg8::EpiRes E{out, out, hb, ssq, D};
          pg8::gemm_phase<pg8::EpiRes, pg8::StaticOrder, true, true>(ldsl, g, S, E); }
        grid.sync();
    }
    { PHASE_IDS
    for (int m = gw; m < M; m += NGW) { f32x4* xr = (f32x4*)(out + (size_t)m * D) + lane; f32x4 v[4]; float s = 0.f;
#pragma unroll
        for (int j = 0; j < 4; ++j) { v[j] = xr[64 * j]; s += (v[j][0] * v[j][0] + v[j][1] * v[j][1]) + (v[j][2] * v[j][2] + v[j][3] * v[j][3]); }
        const float r = __builtin_amdgcn_rsqf(wave_sum(s) * (1.f / D) + 1e-6f);
#pragma unroll
        for (int j = 0; j < 4; ++j) { const f32x4 gn = *((const f32x4*)final_norm + lane + 64 * j); xr[64 * j] = v[j] * r * gn; } } }
}

extern "C" void kernel_launch(void* const* d_in, const int* in_sizes, int n_in, void* d_out, int out_size, void* d_ws, size_t ws_size, hipStream_t stream) {
    static int grid_blocks = 0;
    if (grid_blocks == 0) {
        if (n_in != 22 || out_size != M * D || ws_size < WS_END) { fprintf(stderr, "kernel_launch: unexpected shapes: n_in %d out %d ws %zu (need %zu)\n", n_in, out_size, ws_size, (size_t)WS_END); grid_blocks = -1; return; }
        int dev = 0, cus = 0, per_cu = 0;
        hipGetDevice(&dev);
        hipDeviceGetAttribute(&cus, hipDeviceAttributeMultiprocessorCount, dev);
        if (hipFuncSetAttribute((const void*)fwd_megakernel, hipFuncAttributeMaxDynamicSharedMemorySize, LDS_BYTES) != hipSuccess) { fprintf(stderr, "kernel_launch: hipFuncSetAttribute failed\n"); grid_blocks = -1; return; }
        if (hipOccupancyMaxActiveBlocksPerMultiprocessor(&per_cu, (const void*)fwd_megakernel, NTHR, LDS_BYTES) != hipSuccess || per_cu < 1) { fprintf(stderr, "kernel_launch: occupancy query failed (%d)\n", per_cu); (void)hipGetLastError(); grid_blocks = -1; return; }
        grid_blocks = cus * per_cu;
    }
    if (grid_blocks < 0) return;
    Args a{};
    for (int i = 0; i < 22; ++i) a.in[i] = (const float*)d_in[i];
    a.pos = (const int*)d_in[1]; a.out = (float*)d_out; a.ws = (unsigned char*)d_ws;
    void* kargs[] = {&a};
    hipError_t e = hipLaunchCooperativeKernel((const void*)fwd_megakernel, dim3(grid_blocks), dim3(NTHR), kargs, LDS_BYTES, stream);
    if (e != hipSuccess) fprintf(stderr, "cooperative launch failed: %s (grid %d)\n", hipGetErrorString(e), grid_blocks);
}
```

```cpp
#include <hip/hip_runtime.h>
#include <hip/hip_cooperative_groups.h>
#include <cstdio>
#include <cstdint>
namespace pg8 {
#define PG8_LAS __attribute__((address_space(3)))
typedef unsigned short bf16_t;
typedef short bf16x8 __attribute__((ext_vector_type(8)));
typedef float f32x4 __attribute__((ext_vector_type(4)));
typedef unsigned u32x4 __attribute__((ext_vector_type(4)));
constexpr int BM = 256, BK = 64, HALF = 128, HTB = HALF * BK * 2  , STAGE_BYTES = 8 * HTB, NXCD = 8, WGM = 8;

__host__ __device__ __forceinline__ int lds_byte(int r, int c) { const int st = (r >> 4) * 2 + (c >> 5), rr = r & 15, cc = c & 31, ob = rr * 64 + cc * 2; return st * 1024 + (ob ^ (((ob >> 9) & 1) << 5)); }
__host__ __device__ __forceinline__ void stage_rc(int b, int& R, int& C) { const int st = b / 1024, sb = b % 1024, swz = sb ^ (((sb >> 9) & 1) << 5); R = (st >> 1) * 16 + swz / 64; C = (st & 1) * 32 + (swz % 64) / 2; }
__host__ __device__ __forceinline__ int perm32(int rho) { const int n = rho >> 4, i = rho & 15; return 8 * (i >> 2) + 4 * n + (i & 3); }

struct Unit { int pm, pn; };
struct Gemm { const bf16_t* A; const bf16_t* Bt; int M, N, K; };

struct StaticOrder {
    int nM, nN, nwg, G, c;
    __host__ __device__ void init(int M, int N, int G_, int c_) { nM = M / BM; nN = N / BM; nwg = nM * nN; G = G_; c = c_; }
    __host__ __device__ bool next(int i, Unit& u) const {
        const long L = (long)i * G + c; if (L >= nwg) return false;
        int wgid = (int)L; { const int q = nwg / NXCD, r = nwg % NXCD, xcd = wgid % NXCD, off = wgid / NXCD; wgid = (xcd < r ? xcd * (q + 1) : r * (q + 1) + (xcd - r) * q) + off; }
        const int nig = WGM * nN, gid = wgid / nig, fm = gid * WGM, gsz = (nM - fm) < WGM ? (nM - fm) : WGM;
        u.pm = fm + ((wgid % nig) % gsz); u.pn = (wgid % nig) / gsz; return true;
    }
    __device__ __forceinline__ void a_ready(const Unit&) const {}
    __device__ __forceinline__ void done(const Unit&) const {}
};
__device__ __forceinline__ unsigned cvt_pk_bf16(float lo, float hi) { unsigned r; asm volatile("v_cvt_pk_bf16_f32 %0, %1, %2" : "=v"(r) : "v"(lo), "v"(hi)); return r; }
typedef float f32x2 __attribute__((ext_vector_type(2)));
__device__ __forceinline__ float row_rstd(const float* ssq, int row) {
    const f32x4* p = (const f32x4*)(ssq + (size_t)row * 16);
    const f32x4 a = p[0], b = p[1], c = p[2], d = p[3];
    const f32x4 s = (a + b) + (c + d);
    return __builtin_amdgcn_rsqf(((s[0] + s[1]) + (s[2] + s[3])) * (1.0f / 1024.0f) + 1e-6f);
}
struct EpiBf16S {
    static constexpr bool PERM = true, AFTER_DRAIN = false;
    bf16_t* O0; bf16_t* O1; int split_cols; int ldc; const float* ssq;
    __device__ __forceinline__ void operator()(const f32x4 (&acc)[2][2][4][2], const Unit& u, int wr, int wc, int fr, int fq) const {
        const int row0 = u.pm * BM + wr * 64 + fr; int colt = u.pn * BM; bf16_t* base = O0;
        if (colt >= split_cols) { base = O1; colt -= split_cols; }
        const int col0 = colt + wc * 32 + 8 * fq;
#pragma unroll
        for (int ai = 0; ai < 2; ++ai)
#pragma unroll
            for (int m = 0; m < 4; ++m) { const int row = row0 + ai * HALF + m * 16; const float sc = ssq ? row_rstd(ssq, row) : 1.f;
                bf16_t* rowp = base + (size_t)row * ldc + col0;
#pragma unroll
                for (int bj = 0; bj < 2; ++bj) { const f32x4 v0 = acc[ai][bj][m][0] * sc, v1 = acc[ai][bj][m][1] * sc;
                    u32x4 w; w.x = cvt_pk_bf16(v0[0], v0[1]); w.y = cvt_pk_bf16(v0[2], v0[3]); w.z = cvt_pk_bf16(v1[0], v1[1]); w.w = cvt_pk_bf16(v1[2], v1[3]);
                    *(u32x4*)(rowp + bj * HALF) = w; } }
    }
};
struct EpiF32S {
    static constexpr bool PERM = false, AFTER_DRAIN = false;
    float* O; int ldc; const float* ssq;
    __device__ __forceinline__ void operator()(const f32x4 (&acc)[2][2][4][2], const Unit& u, int wr, int wc, int fr, int fq) const {
        const int row0 = u.pm * BM + wr * 64 + fr; const int col0 = u.pn * BM + wc * 32 + 4 * fq;
#pragma unroll
        for (int ai = 0; ai < 2; ++ai)
#pragma unroll
            for (int m = 0; m < 4; ++m) { const int row = row0 + ai * HALF + m * 16; const float sc = row_rstd(ssq, row);
                float* rowp = O + (size_t)row * ldc + col0;
#pragma unroll
                for (int bj = 0; bj < 2; ++bj)
#pragma unroll
                    for (int n = 0; n < 2; ++n) *(f32x4*)(rowp + bj * HALF + n * 16) = acc[ai][bj][m][n] * sc; }
    }
};
struct EpiRes {
    static constexpr bool PERM = false, AFTER_DRAIN = false;
    const float* base; float* out; bf16_t* hb; float* ssq; int ldc;
    __device__ __forceinline__ void operator()(const f32x4 (&acc)[2][2][4][2], const Unit& u, int wr, int wc, int fr, int fq) const {
        typedef unsigned u32x2v __attribute__((ext_vector_type(2)));
        const int row0 = u.pm * BM + wr * 64 + fr; const int col0 = u.pn * BM + wc * 32 + 4 * fq;
#pragma unroll
        for (int ai = 0; ai < 2; ++ai)
#pragma unroll
            for (int m = 0; m < 4; ++m) { const int row = row0 + ai * HALF + m * 16; const size_t off = (size_t)row * ldc + col0; float s = 0.f;
#pragma unroll
                for (int bj = 0; bj < 2; ++bj)
#pragma unroll
                    for (int n = 0; n < 2; ++n) { const f32x4 h = *(const f32x4*)(base + off + bj * HALF + n * 16) + acc[ai][bj][m][n];
                        *(f32x4*)(out + off + bj * HALF + n * 16) = h;
                        u32x2v w; w.x = cvt_pk_bf16(h[0], h[1]); w.y = cvt_pk_bf16(h[2], h[3]); *(u32x2v*)(hb + off + bj * HALF + n * 16) = w;
                        s += (h[0] * h[0] + h[1] * h[1]) + (h[2] * h[2] + h[3] * h[3]); }
                s += __shfl_xor(s, 16); s += __shfl_xor(s, 32);
                if (fq == 0) ssq[(size_t)row * 16 + u.pn * 4 + wc] = s;
                asm volatile("" ::: "memory"); }
    }
};
template <class Epi, class Sched, bool ALIGN_EPI = false, bool SP2 = false>
__device__ __forceinline__ void gemm_phase(PG8_LAS unsigned char* lds, const Gemm g, const Sched& S, const Epi& E) {
    int tid_ = threadIdx.x; asm volatile("" : "+v"(tid_));
    const int tid = tid_, wid = __builtin_amdgcn_readfirstlane(tid >> 6), lane = tid & 63, wr = wid >> 2, wc = wid & 3, fr = lane & 15, fq = lane >> 4;
    const int K = g.K, nt = K / BK;
    unsigned voffA[2], voffB[2];
#pragma unroll
    for (int i = 0; i < 2; ++i) { int R, C; stage_rc(tid * 16 + i * 8192, R, C); const int Rb = Epi::PERM ? ((R & ~31) + perm32(R & 31)) : R;
        voffA[i] = (unsigned)(R * K + C) * 2u; voffB[i] = (unsigned)(Rb * K + C) * 2u; }
    const size_t kstep = (size_t)(BK * 2);
    const size_t hstep = (size_t)HALF * K * 2;
    const size_t tstep = 2 * hstep;
    const unsigned ldsw = (unsigned)wid * 1024u;
    const int aoff = lds_byte(wr * 64 + fr, fq * 8), boff = lds_byte(wc * 32 + fr, fq * 8);
#define PG8_SA(b, h) (((b) * 2 + (h)) * HTB)
#define PG8_SB(b, h) ((4 + (b) * 2 + (h)) * HTB)
#define PG8_STAGE(bufoff, gbase, voff) do { _Pragma("unroll") for (int _i = 0; _i < 2; ++_i) \
        __builtin_amdgcn_global_load_lds((const unsigned*)((const char*)(gbase) + (voff)[_i]), (PG8_LAS unsigned*)(lds + (bufoff) + ldsw + _i * 8192), 16, 0, 0); } while (0)
#define PG8_LDA(dst, b, h) do { _Pragma("unroll") for (int m = 0; m < 4; ++m) _Pragma("unroll") for (int k = 0; k < 2; ++k) dst[m][k] = *(const PG8_LAS bf16x8*)(lds + PG8_SA(b, h) + aoff + m * 2048 + k * 1024); } while (0)
#define PG8_LDB(dst, b, h) do { _Pragma("unroll") for (int n = 0; n < 2; ++n) _Pragma("unroll") for (int k = 0; k < 2; ++k) dst[n][k] = *(const PG8_LAS bf16x8*)(lds + PG8_SB(b, h) + boff + n * 2048 + k * 1024); } while (0)
#define PG8_MMA(ai, bj, At, Bt) do { __builtin_amdgcn_s_setprio(1); _Pragma("unroll") for (int m = 0; m < 4; ++m) _Pragma("unroll") for (int n = 0; n < 2; ++n) _Pragma("unroll") for (int k = 0; k < 2; ++k) \
        acc[ai][bj][m][n] = __builtin_amdgcn_mfma_f32_16x16x32_bf16(Bt[n][k], At[m][k], acc[ai][bj][m][n], 0, 0, 0); __builtin_amdgcn_s_setprio(0); } while (0)
#define PG8_WAIT_V(n) asm volatile("s_waitcnt vmcnt(" #n ")" ::: "memory")
#define PG8_WAIT_L(n) asm volatile("s_waitcnt lgkmcnt(" #n ")" ::: "memory")
#define PG8_BAR __builtin_amdgcn_s_barrier()
#define PG8_SCHED __builtin_amdgcn_sched_barrier(0)
    Unit cur, nxt; int ui = 0;
    if (!S.next(0, cur)) return;
    f32x4 acc[2][2][4][2];
#pragma unroll
    for (int a = 0; a < 2; ++a)
#pragma unroll
        for (int b = 0; b < 2; ++b)
#pragma unroll
            for (int m = 0; m < 4; ++m)
#pragma unroll
                for (int n = 0; n < 2; ++n) acc[a][b][m][n] = (f32x4){0.f, 0.f, 0.f, 0.f};
    bf16x8 At[4][2], B0[2][2], B1[2][2];
    const char* cA = (const char*)g.A + (size_t)cur.pm * tstep; const char* cB = (const char*)g.Bt + (size_t)cur.pn * tstep;
    S.a_ready(cur);
    if constexpr (SP2) {
        PG8_STAGE(PG8_SB(0, 0), cB, voffB); PG8_STAGE(PG8_SB(0, 1), cB + hstep, voffB); PG8_STAGE(PG8_SA(0, 0), cA, voffA); PG8_STAGE(PG8_SA(0, 1), cA + hstep, voffA);
        if (wr == 1) PG8_BAR;
        PG8_WAIT_V(2); PG8_BAR;
        PG8_STAGE(PG8_SB(1, 0), cB + kstep, voffB); PG8_STAGE(PG8_SA(1, 0), cA + kstep, voffA); PG8_STAGE(PG8_SB(1, 1), cB + hstep + kstep, voffB);
        PG8_WAIT_V(6); PG8_BAR;
    } else {
        PG8_STAGE(PG8_SB(0, 0), cB, voffB); PG8_STAGE(PG8_SA(0, 0), cA, voffA); PG8_STAGE(PG8_SB(0, 1), cB + hstep, voffB); PG8_STAGE(PG8_SA(0, 1), cA + hstep, voffA);
        if (wr == 1) PG8_BAR;
        PG8_WAIT_V(4); PG8_BAR;
        PG8_STAGE(PG8_SB(1, 0), cB + kstep, voffB); PG8_STAGE(PG8_SA(1, 0), cA + kstep, voffA); PG8_STAGE(PG8_SB(1, 1), cB + hstep + kstep, voffB);
        PG8_WAIT_V(6); PG8_BAR;
    }
    for (;;) {
        const bool has_next = S.next(ui + 1, nxt);
        const char* nA = has_next ? (const char*)g.A + (size_t)nxt.pm * tstep : cA; const char* nB = has_next ? (const char*)g.Bt + (size_t)nxt.pn * tstep : cB;
        for (int t = 0; t < nt; t += 2) {
            const bool last = (t == nt - 2);
            const char* a1 = cA + (size_t)(t + 1) * kstep;
            const char* a2 = last ? nA : cA + (size_t)(t + 2) * kstep; const char* b2 = last ? nB : cB + (size_t)(t + 2) * kstep;
            const char* a3 = a2 + kstep; const char* b3 = b2 + kstep;
            if (last && has_next) S.a_ready(nxt);
            if constexpr (SP2) {
            PG8_LDB(B0, 0, 0); PG8_LDB(B1, 0, 1); PG8_SCHED; PG8_LDA(At, 0, 0); PG8_STAGE(PG8_SA(1, 1), a1 + hstep, voffA);
            PG8_WAIT_V(8); PG8_WAIT_L(0); PG8_BAR; PG8_MMA(0, 0, At, B0); PG8_MMA(0, 1, At, B1); PG8_BAR; PG8_SCHED;
            PG8_LDA(At, 0, 1); PG8_STAGE(PG8_SB(0, 0), b2, voffB); PG8_STAGE(PG8_SB(0, 1), b2 + hstep, voffB); PG8_STAGE(PG8_SA(0, 0), a2, voffA);
            PG8_WAIT_V(8); PG8_WAIT_L(0); PG8_BAR; PG8_MMA(1, 0, At, B0); PG8_MMA(1, 1, At, B1); PG8_BAR; PG8_SCHED;
            PG8_LDB(B0, 1, 0); PG8_LDB(B1, 1, 1); PG8_SCHED; PG8_LDA(At, 1, 0); PG8_STAGE(PG8_SA(0, 1), a2 + hstep, voffA);
            PG8_WAIT_V(8); PG8_WAIT_L(0); PG8_BAR; PG8_MMA(0, 0, At, B0); PG8_MMA(0, 1, At, B1); PG8_BAR; PG8_SCHED;
            PG8_LDA(At, 1, 1); PG8_STAGE(PG8_SB(1, 0), b3, voffB); PG8_STAGE(PG8_SB(1, 1), b3 + hstep, voffB); PG8_STAGE(PG8_SA(1, 0), a3, voffA);
            PG8_WAIT_V(8); PG8_WAIT_L(0); PG8_BAR; PG8_MMA(1, 0, At, B0); PG8_MMA(1, 1, At, B1); PG8_BAR; PG8_SCHED;
            } else {
            PG8_LDB(B0, 0, 0); PG8_SCHED; PG8_LDA(At, 0, 0); PG8_STAGE(PG8_SA(1, 1), a1 + hstep, voffA);
            PG8_WAIT_L(8); PG8_BAR; PG8_WAIT_L(0); PG8_MMA(0, 0, At, B0); PG8_BAR; PG8_SCHED;
            PG8_LDB(B1, 0, 1); PG8_STAGE(PG8_SB(0, 0), b2, voffB);
            PG8_BAR; PG8_WAIT_L(0); PG8_MMA(0, 1, At, B1); PG8_BAR;
            PG8_LDA(At, 0, 1); PG8_STAGE(PG8_SA(0, 0), a2, voffA);
            PG8_BAR; PG8_WAIT_L(0); PG8_MMA(1, 0, At, B0); PG8_BAR; PG8_SCHED;
            PG8_STAGE(PG8_SB(0, 1), b2 + hstep, voffB);
            PG8_WAIT_V(6); PG8_BAR; PG8_MMA(1, 1, At, B1); PG8_BAR;
            PG8_LDB(B0, 1, 0); PG8_SCHED; PG8_LDA(At, 1, 0); PG8_STAGE(PG8_SA(0, 1), a2 + hstep, voffA);
            PG8_WAIT_L(8); PG8_BAR; PG8_WAIT_L(0); PG8_MMA(0, 0, At, B0); PG8_BAR; PG8_SCHED;
            PG8_LDB(B1, 1, 1); PG8_STAGE(PG8_SB(1, 0), b3, voffB);
            PG8_BAR; PG8_WAIT_L(0); PG8_MMA(0, 1, At, B1); PG8_BAR;
            PG8_LDA(At, 1, 1); PG8_STAGE(PG8_SA(1, 0), a3, voffA);
            PG8_BAR; PG8_WAIT_L(0); PG8_MMA(1, 0, At, B0); PG8_BAR; PG8_SCHED;
            PG8_STAGE(PG8_SB(1, 1), b3 + hstep, voffB);
            PG8_WAIT_V(6); PG8_BAR; PG8_MMA(1, 1, At, B1); PG8_BAR;
            }
        }
        if constexpr (ALIGN_EPI) { if (wr == 0) PG8_BAR; }
        if constexpr (!Epi::AFTER_DRAIN) { E(acc, cur, wr, wc, fr, fq); S.done(cur); }
        if (!has_next) break;
#pragma unroll
        for (int a = 0; a < 2; ++a)
#pragma unroll
            for (int b = 0; b < 2; ++b)
#pragma unroll
                for (int m = 0; m < 4; ++m)
#pragma unroll
                    for (int n = 0; n < 2; ++n) acc[a][b][m][n] = (f32x4){0.f, 0.f, 0.f, 0.f};
        cur = nxt; cA = nA; cB = nB; ++ui;
        if constexpr (ALIGN_EPI) { if (wr == 1) PG8_BAR; }
    }
    PG8_WAIT_V(0);
    if constexpr (!ALIGN_EPI) { if (wr == 0) PG8_BAR; }
    PG8_BAR;
    if constexpr (Epi::AFTER_DRAIN) { E.fused(acc, cur, wr, wc, fr, fq, lds, wid, lane); S.done(cur); }
#undef PG8_SA
#undef PG8_SB
#undef PG8_STAGE
#undef PG8_LDA
#undef PG8_LDB
#undef PG8_MMA
#undef PG8_WAIT_V
#undef PG8_WAIT_L
#undef PG8_BAR
#undef PG8_SCHED
}
}

namespace att {
using bf16x8 = __attribute__((ext_vector_type(8))) short;
using s16x4  = __attribute__((ext_vector_type(4))) short;
using f32x16 = __attribute__((ext_vector_type(16))) float;
using f32x4  = __attribute__((ext_vector_type(4))) float;
using u32x4  = __attribute__((ext_vector_type(4))) unsigned;
constexpr float SCALE = 0.07216878364870322f;
constexpr float THR = 8.f;
constexpr int SHM_V = 64 * 128 * 2, SHM_KN = 64 * 128 * 2, SHM_KR = 64 * 64 * 2;
constexpr int OFF_V = 0, OFF_KN = 2 * SHM_V, OFF_KR = OFF_KN + 2 * SHM_KN, OFF_WS = OFF_KR + 2 * SHM_KR, LDS_BYTES = OFF_WS + 8 * 64 * 4;
#define KSWZ(row, colB) ((row) * 256 + ((colB) ^ (((row) & 7) << 4)))
#define KRSWZ(row, colB) ((row) * 128 + ((colB) ^ (((row) & 7) << 4)))
#define SBAR() __builtin_amdgcn_sched_barrier(0)
__device__ __forceinline__ int crow(int r, int hi) { return (r & 3) + 8 * (r >> 2) + 4 * hi; }
__device__ __forceinline__ unsigned cvtpk(float lo, float hi) { unsigned r; asm volatile("v_cvt_pk_bf16_f32 %0, %1, %2" : "=v"(r) : "v"(lo), "v"(hi)); return r; }
__device__ __forceinline__ float bf_lo(unsigned w) { return __uint_as_float(w << 16); }
__device__ __forceinline__ float bf_hi(unsigned w) { return __uint_as_float(w & 0xffff0000u); }

__device__ __forceinline__ void partialSM(f32x16& p0, f32x16& p1, float& m_reg, float& alpha) {
  constexpr float C = SCALE * 1.4426950408889634f;
  float pmax = p0[0];
#pragma unroll
  for (int r = 1; r < 16; ++r) pmax = fmaxf(pmax, p0[r]);
#pragma unroll
  for (int r = 0; r < 16; ++r) pmax = fmaxf(pmax, p1[r]);
  { auto rr = __builtin_amdgcn_permlane32_swap(__float_as_uint(pmax), __float_as_uint(pmax), false, false);
    pmax = fmaxf(__uint_as_float(rr[0]), __uint_as_float(rr[1])); }
  float mn;
  if (__builtin_expect(__all(pmax - m_reg <= THR / SCALE), 1)) { mn = m_reg; alpha = 1.f; }
  else { mn = fmaxf(m_reg, pmax); alpha = __builtin_amdgcn_exp2f((m_reg - mn) * C); m_reg = mn; }
  const float mnC = -mn * C;
#pragma unroll
  for (int r = 0; r < 16; ++r) p0[r] = __builtin_amdgcn_exp2f(fmaf(p0[r], C, mnC));
#pragma unroll
  for (int r = 0; r < 16; ++r) p1[r] = __builtin_amdgcn_exp2f(fmaf(p1[r], C, mnC));
}
__device__ __forceinline__ void finishSM(f32x16& p0, f32x16& p1, float alpha, float& l_reg, bf16x8& pa0, bf16x8& pa1, bf16x8& pa2, bf16x8& pa3) {
  float ps = 0;
#pragma unroll
  for (int r = 0; r < 16; ++r) ps += p0[r];
#pragma unroll
  for (int r = 0; r < 16; ++r) ps += p1[r];
  { auto rr = __builtin_amdgcn_permlane32_swap(__float_as_uint(ps), __float_as_uint(ps), false, false);
    ps = __uint_as_float(rr[0]) + __uint_as_float(rr[1]); }
  l_reg = l_reg * alpha + ps;
#define PK4(P, BASE, OUT) do { unsigned a0 = cvtpk(P[BASE + 0], P[BASE + 1]), a1 = cvtpk(P[BASE + 2], P[BASE + 3]);   \
    unsigned b0 = cvtpk(P[BASE + 4], P[BASE + 5]), b1 = cvtpk(P[BASE + 6], P[BASE + 7]);                              \
    auto r0 = __builtin_amdgcn_permlane32_swap(a0, b0, false, false); auto r1 = __builtin_amdgcn_permlane32_swap(a1, b1, false, false); \
    u32x4 w = {r0[0], r1[0], r0[1], r1[1]}; OUT = *reinterpret_cast<bf16x8*>(&w); } while (0)
  PK4(p0, 0, pa0); PK4(p0, 8, pa1); PK4(p1, 0, pa2); PK4(p1, 8, pa3);
#undef PK4
}
__device__ __forceinline__ void qkt(f32x16& p0, f32x16& p1, const char* Kn, const char* Kr, const bf16x8* qr, int r32, int hi) {
  p0 = f32x16{}; p1 = f32x16{};
#pragma unroll
  for (int d0 = 0; d0 < 8; ++d0) { const int cb = (d0 * 16 + hi * 8) * 2;
    const bf16x8 b0 = *reinterpret_cast<const bf16x8*>(Kn + KSWZ(r32, cb));
    const bf16x8 b1 = *reinterpret_cast<const bf16x8*>(Kn + KSWZ(32 + r32, cb));
    p0 = __builtin_amdgcn_mfma_f32_32x32x16_bf16(b0, qr[d0], p0, 0, 0, 0);
    p1 = __builtin_amdgcn_mfma_f32_32x32x16_bf16(b1, qr[d0], p1, 0, 0, 0); }
#pragma unroll
  for (int d0 = 0; d0 < 4; ++d0) { const int cb = (d0 * 16 + hi * 8) * 2;
    const bf16x8 b0 = *reinterpret_cast<const bf16x8*>(Kr + KRSWZ(r32, cb));
    const bf16x8 b1 = *reinterpret_cast<const bf16x8*>(Kr + KRSWZ(32 + r32, cb));
    p0 = __builtin_amdgcn_mfma_f32_32x32x16_bf16(b0, qr[8 + d0], p0, 0, 0, 0);
    p1 = __builtin_amdgcn_mfma_f32_32x32x16_bf16(b1, qr[8 + d0], p1, 0, 0, 0); }
}
__device__ __forceinline__ int v_st(int k, int c) { const int kk = (k & ~0xC) | ((k & 4) << 1) | ((k & 8) >> 1); return ((kk >> 3) * 4 + (c >> 5)) * 512 + ((kk & 7) * 32 + (c & 31)) * 2; }
__device__ __forceinline__ int v_rd_base(int lane) { return ((lane & 3) << 3) | (((lane >> 2) & 3) << 6) | (((lane >> 4) & 1) << 5) | (((lane >> 5) & 1) << 8); }
constexpr int v_rd_off(int d0, int ks, int half) { return d0 * 512 + ks * 4096 + half * 2048; }
template <int OFF> __device__ __forceinline__ s16x4 tr_read(int vb) {
  s16x4 r; asm volatile("ds_read_b64_tr_b16 %0, %1 offset:%2" : "=&v"(r) : "v"(vb), "i"(OFF) : "memory"); return r;
}
template <int D0> __device__ __forceinline__ void pv_one(f32x16& od, int vb, bf16x8 pa0, bf16x8 pa1, bf16x8 pa2, bf16x8 pa3) {
  const s16x4 l0 = tr_read<v_rd_off(D0, 0, 0)>(vb), h0 = tr_read<v_rd_off(D0, 0, 1)>(vb), l1 = tr_read<v_rd_off(D0, 1, 0)>(vb), h1 = tr_read<v_rd_off(D0, 1, 1)>(vb);
  const s16x4 l2 = tr_read<v_rd_off(D0, 2, 0)>(vb), h2 = tr_read<v_rd_off(D0, 2, 1)>(vb), l3 = tr_read<v_rd_off(D0, 3, 0)>(vb), h3 = tr_read<v_rd_off(D0, 3, 1)>(vb);
  asm volatile("s_waitcnt lgkmcnt(0)" ::: "memory"); SBAR();
#define PK(L, H) (bf16x8){L[0], L[1], L[2], L[3], H[0], H[1], H[2], H[3]}
  od = __builtin_amdgcn_mfma_f32_32x32x16_bf16(pa0, PK(l0, h0), od, 0, 0, 0);
  od = __builtin_amdgcn_mfma_f32_32x32x16_bf16(pa1, PK(l1, h1), od, 0, 0, 0);
  od = __builtin_amdgcn_mfma_f32_32x32x16_bf16(pa2, PK(l2, h2), od, 0, 0, 0);
  od = __builtin_amdgcn_mfma_f32_32x32x16_bf16(pa3, PK(l3, h3), od, 0, 0, 0);
#undef PK
}
__device__ __forceinline__ void pv_d0(f32x16* o, int vb, bf16x8 pa0, bf16x8 pa1, bf16x8 pa2, bf16x8 pa3) {
  pv_one<0>(o[0], vb, pa0, pa1, pa2, pa3); pv_one<1>(o[1], vb, pa0, pa1, pa2, pa3); pv_one<2>(o[2], vb, pa0, pa1, pa2, pa3); pv_one<3>(o[3], vb, pa0, pa1, pa2, pa3);
}
__device__ __forceinline__ void rope_pair(bf16x8& x1, bf16x8& x2, const float* cs, int i0) {
  const f32x4 c0 = *(const f32x4*)(cs + i0), c1 = *(const f32x4*)(cs + i0 + 4), s0 = *(const f32x4*)(cs + 32 + i0), s1 = *(const f32x4*)(cs + 32 + i0 + 4);
  const float c[8] = {c0[0], c0[1], c0[2], c0[3], c1[0], c1[1], c1[2], c1[3]}, s[8] = {s0[0], s0[1], s0[2], s0[3], s1[0], s1[1], s1[2], s1[3]};
  u32x4 a = *reinterpret_cast<u32x4*>(&x1), b = *reinterpret_cast<u32x4*>(&x2), oa, ob;
#pragma unroll
  for (int w = 0; w < 4; ++w) {
    const float a0 = bf_lo(a[w]), a1 = bf_hi(a[w]), b0 = bf_lo(b[w]), b1 = bf_hi(b[w]);
    oa[w] = cvtpk(a0 * c[2 * w] - b0 * s[2 * w], a1 * c[2 * w + 1] - b1 * s[2 * w + 1]);
    ob[w] = cvtpk(b0 * c[2 * w] + a0 * s[2 * w], b1 * c[2 * w + 1] + a1 * s[2 * w + 1]); }
  x1 = *reinterpret_cast<bf16x8*>(&oa); x2 = *reinterpret_cast<bf16x8*>(&ob);
}
__device__ __forceinline__ void attn_unit(const unsigned short* __restrict__ Q, const unsigned short* __restrict__ Kn, const unsigned short* __restrict__ Kr, const unsigned short* __restrict__ V,
                                          const float* __restrict__ cs, unsigned short* __restrict__ O, int b, int h, int qb, char* lds) {
  int tid_ = threadIdx.x; asm volatile("" : "+v"(tid_));
  const int tid = tid_, wid = __builtin_amdgcn_readfirstlane(tid >> 6), lane = tid & 63, r32 = lane & 31, hi = lane >> 5;
  const long rowbase = (long)b * 2048; const int q0 = qb * 256;
  char* V_lds = lds + OFF_V; char* Kn_lds = lds + OFF_KN; char* Kr_lds = lds + OFF_KR;
  float* ws = (float*)(lds + OFF_WS) + wid * 64; float* li_l = ws; float* al_l = ws + 32;
  float m_reg = -1e30f, l_reg = 0; f32x16 o[4] = {}; bf16x8 qr[12];
  const long qrow = rowbase + q0 + wid * 32 + r32;
  const unsigned short* Qw = Q + qrow * 1536 + h * 192 + hi * 8;
#pragma unroll
  for (int d0 = 0; d0 < 12; ++d0) qr[d0] = *reinterpret_cast<const bf16x8*>(Qw + d0 * 16);
  rope_pair(qr[8], qr[10], cs + qrow * 64, hi * 8);
  rope_pair(qr[9], qr[11], cs + qrow * 64, 16 + hi * 8);
  const int sr = tid >> 4, sc = (tid & 15) * 8, vst0 = v_st(sr, sc), vst1 = v_st(32 + sr, sc);
  const int rr_ = tid >> 3, rc_ = (tid & 7) * 8;
  const int vb0 = (int)(uintptr_t)V_lds + v_rd_base(lane);
  const unsigned short* Knh = Kn + rowbase * 1024 + h * 128; const unsigned short* Vh = V + rowbase * 1024 + h * 128; const unsigned short* Krb = Kr + rowbase * 64;
  bf16x8 vs0, vs1, ks0, ks1, kr0;
#define SLOAD(k0) do { vs0 = *reinterpret_cast<const bf16x8*>(&Vh[(long)((k0) + sr) * 1024 + sc]); vs1 = *reinterpret_cast<const bf16x8*>(&Vh[(long)((k0) + 32 + sr) * 1024 + sc]); \
    ks0 = *reinterpret_cast<const bf16x8*>(&Knh[(long)((k0) + sr) * 1024 + sc]); ks1 = *reinterpret_cast<const bf16x8*>(&Knh[(long)((k0) + 32 + sr) * 1024 + sc]); \
    kr0 = *reinterpret_cast<const bf16x8*>(&Krb[(long)((k0) + rr_) * 64 + rc_]); } while (0)
#define SWRITE(bb) do { *(bf16x8*)(V_lds + (bb) * SHM_V + vst0) = vs0; *(bf16x8*)(V_lds + (bb) * SHM_V + vst1) = vs1; \
    *(bf16x8*)(Kn_lds + (bb) * SHM_KN + KSWZ(sr, sc * 2)) = ks0; *(bf16x8*)(Kn_lds + (bb) * SHM_KN + KSWZ(32 + sr, sc * 2)) = ks1; \
    *(bf16x8*)(Kr_lds + (bb) * SHM_KR + KRSWZ(rr_, rc_ * 2)) = kr0; } while (0)
  const int NT = 4 * (qb + 1);
  const int myNT = 4 * qb + (wid >> 1) + 1;
  SLOAD(0); SWRITE(0);
  for (int j = 0; j < NT; ++j) {
    __syncthreads();
    if (j + 1 < NT) SLOAD((j + 1) * 64);
    if (j < myNT) {
      f32x16 p0, p1; float alpha; bf16x8 pa0, pa1, pa2, pa3;
      qkt(p0, p1, Kn_lds + (j & 1) * SHM_KN, Kr_lds + (j & 1) * SHM_KR, qr, r32, hi);
      partialSM(p0, p1, m_reg, alpha);
      if (__any(alpha < 1.f)) { if (hi == 0) al_l[r32] = alpha; asm volatile("s_waitcnt lgkmcnt(0)" ::: "memory");
#pragma unroll
        for (int d = 0; d < 4; ++d)
#pragma unroll
          for (int r = 0; r < 16; ++r) o[d][r] *= al_l[crow(r, hi)]; }
      finishSM(p0, p1, alpha, l_reg, pa0, pa1, pa2, pa3); SBAR();
      pv_d0(o, vb0 + (j & 1) * SHM_V, pa0, pa1, pa2, pa3);
    }
    if (j + 1 < NT) SWRITE((j + 1) & 1);
  }
  if (hi == 0) li_l[r32] = l_reg; asm volatile("s_waitcnt lgkmcnt(0)" ::: "memory");
  float rli[16];
#pragma unroll
  for (int r = 0; r < 16; ++r) rli[r] = __builtin_amdgcn_rcpf(li_l[crow(r, hi)]);
  unsigned short* Ow = O + (rowbase + q0 + wid * 32) * 1024 + h * 128;
#pragma unroll
  for (int r = 0; r < 16; ++r) { const int orow = crow(r, hi);
#pragma unroll
    for (int d0 = 0; d0 < 4; ++d0) { const unsigned w = cvtpk(o[d0][r] * rli[r], 0.f); Ow[(long)orow * 1024 + d0 * 32 + r32] = (unsigned short)(w & 0xffffu); } }
  __syncthreads();
#undef SLOAD
#undef SWRITE
}
#undef SBAR
}

namespace cg = cooperative_groups;
#ifndef PROBE_ATT
#define PROBE_ATT 1
#endif
#ifndef PROBE_SYNC
#define PROBE_SYNC 0
#endif
#ifndef PROBE_PRO
#define PROBE_PRO 1
#endif
#ifndef PROBE_ELT
#define PROBE_ELT 1
#endif
#define LAS __attribute__((address_space(3)))
typedef unsigned short bf16;
typedef float f32x4 __attribute__((ext_vector_type(4)));
typedef float f32x2 __attribute__((ext_vector_type(2)));
typedef unsigned v4u __attribute__((ext_vector_type(4)));
typedef unsigned v2u __attribute__((ext_vector_type(2)));
constexpr int NWAVES = 8, NTHR = 512;
constexpr int M = 16384, D = 1024, SEQ = 2048, DFF = 2816, NUP = 2 * DFF, NSC = 3 * D, NCOMB = 768, NKV = 2048, NQ = 1536, KVL = 256, QL = 384;
constexpr size_t MiB = 1u << 20;
constexpr size_t WS_SSQ = 0;
constexpr size_t WS_CS = 1 * MiB;
constexpr size_t WS_WIN = 5 * MiB;
constexpr size_t WS_WOUT = 11 * MiB;
constexpr size_t WS_WUP = 13 * MiB;
constexpr size_t WS_WDN = 24 * MiB;
constexpr size_t WS_WCOMB = 30 * MiB;
constexpr size_t WS_WUKV = 32 * MiB;
constexpr size_t WS_WUQ = 33 * MiB;
constexpr size_t WS_WO = 35 * MiB;
constexpr size_t WS_HB = 37 * MiB;
constexpr size_t WS_BIG = 69 * MiB;
constexpr size_t WS_BAR = WS_BIG + 176 * MiB;
constexpr size_t WS_END = WS_BAR + 1 * MiB;
constexpr size_t HB_CKV = WS_HB, HB_CQ = WS_HB + 8 * MiB, HB_KR = WS_HB + 20 * MiB;
constexpr size_t BIG_G = WS_BIG, BIG_V = WS_BIG + 88 * MiB;
constexpr size_t BIG_SC = WS_BIG, BIG_MIX = WS_BIG + 96 * MiB;
constexpr size_t BIG_COMB = WS_BIG, BIG_O = WS_BIG, BIG_Q = WS_BIG + 48 * MiB, BIG_KN = WS_BIG + 96 * MiB, BIG_VV = WS_BIG + 128 * MiB;
constexpr int RING_BYTES = 131072, LDSX_OFF = RING_BYTES, LDS_BYTES = RING_BYTES + 8192;

#define RLX_AGENT __ATOMIC_RELAXED, __HIP_MEMORY_SCOPE_AGENT
#define XB_TMO      128
#define XB_XCNT(j)  (256  + 64 * (j))
#define XB_XSUB(j)  (1280 + 64 * (j))
#define XB_XGEN(j)  (2304 + 64 * (j))
#define XB_TOP      3328
#define XB_TOPGEN   3392
#define XCD_BAR_WORDS 3456
#define XB_SPIN_CAP (1u << 18)

__device__ __forceinline__ unsigned xb_ld(unsigned* p)              { return __hip_atomic_load(p, __ATOMIC_RELAXED, __HIP_MEMORY_SCOPE_AGENT); }
__device__ __forceinline__ unsigned xb_add(unsigned* p, unsigned v) { return __hip_atomic_fetch_add(p, v, __ATOMIC_RELAXED, __HIP_MEMORY_SCOPE_AGENT); }
__device__ __forceinline__ unsigned xb_xcc_id() { return (unsigned)__builtin_amdgcn_s_getreg((3 << 11) | 20) & 0xFu; }
#define XB_SPIN(cond, bar) do { unsigned _sp = 0; while (cond) { __builtin_amdgcn_s_sleep(1); \
    if ((++_sp & 255u) == 0u) { if (xb_ld(&(bar)[XB_TMO])) break; if (_sp > XB_SPIN_CAP) { atomicAdd(&(bar)[XB_TMO], 1u); break; } } } } while (0)

struct XcdBarrier {
    unsigned* bar; unsigned x;
    volatile LAS unsigned* st;
};

__device__ __forceinline__ XcdBarrier xcd_barrier_post(unsigned* bar, volatile LAS unsigned* st) {
    XcdBarrier b; b.bar = bar; b.x = xb_xcc_id(); b.st = st;
    if (threadIdx.x == 0) (void)xb_add(&bar[XB_XCNT(b.x)], 1u);
    return b;
}
__device__ __forceinline__ void xcd_barrier_complete(unsigned* bar, unsigned x, unsigned& nloc, unsigned& nx) {
    const unsigned G = gridDim.x * gridDim.y * gridDim.z;
    unsigned sum, cnt, mine, sp = 0u;
    for (;;) {
        sum = 0u; cnt = 0u; mine = 0u;
#pragma unroll
        for (unsigned j = 0; j < 16; ++j) { const unsigned c = xb_ld(&bar[XB_XCNT(j)]); sum += c; cnt += (c > 0u) ? 1u : 0u; mine = (j == x) ? c : mine; }
        if (sum == G) break;
        __builtin_amdgcn_s_sleep(1);
        if ((++sp & 255u) == 0u) { if (xb_ld(&bar[XB_TMO])) break; if (sp > XB_SPIN_CAP) { atomicAdd(&bar[XB_TMO], 1u); break; } }
    }
    nloc = mine > 0u ? mine : 1u; nx = cnt > 0u ? cnt : 1u;
}

__device__ __forceinline__ void xcd_barrier(const XcdBarrier& b) {
    asm volatile("s_waitcnt vmcnt(0)" ::: "memory");
    __syncthreads();
    if (threadIdx.x == 0) {
        unsigned* bar = b.bar;
        __builtin_amdgcn_s_waitcnt(0);
        unsigned nloc = b.st[0], nx = b.st[1];
        if (nloc == 0u) { xcd_barrier_complete(bar, b.x, nloc, nx); b.st[0] = nloc; b.st[1] = nx; }
        const unsigned old = xb_add(&bar[XB_XSUB(b.x)], 1u);
        const unsigned gen = old / nloc;
        if (old + 1u == (gen + 1u) * nloc) {
            __builtin_amdgcn_fence(__ATOMIC_RELEASE, "agent");
            asm volatile("s_waitcnt vmcnt(0)" ::: "memory");
            const unsigned og = xb_add(&bar[XB_TOP], 1u);
            const unsigned tg = og / nx;
            if (og + 1u == (tg + 1u) * nx) xb_add(&bar[XB_TOPGEN], 1u);
            else XB_SPIN(xb_ld(&bar[XB_TOPGEN]) == tg, bar);
            __builtin_amdgcn_fence(__ATOMIC_ACQUIRE, "agent");
            xb_add(&bar[XB_XGEN(b.x)], 1u);
            asm volatile("s_waitcnt vmcnt(0)" ::: "memory");
        } else {
            XB_SPIN(xb_ld(&bar[XB_XGEN(b.x)]) == gen, bar);
            __builtin_amdgcn_fence(__ATOMIC_ACQUIRE, "agent");
            asm volatile("s_waitcnt vmcnt(0)" ::: "memory");
        }
    }
    __syncthreads();
}

struct Args { const float* in[22]; const int* pos; float* out; unsigned char* ws; };

__device__ __forceinline__ unsigned f2bf(float f) { unsigned u = __builtin_bit_cast(unsigned, f); return (u + 0x7fffu + ((u >> 16) & 1u)) >> 16; }
__device__ __forceinline__ unsigned pk2(float lo, float hi) { return f2bf(lo) | (f2bf(hi) << 16); }
__device__ __forceinline__ float bflo(unsigned w) { return __uint_as_float(w << 16); }
__device__ __forceinline__ float bfhi(unsigned w) { return __uint_as_float(w & 0xffff0000u); }
__device__ __forceinline__ float wave_sum(float v) {
#pragma unroll
    for (int o = 1; o < 64; o <<= 1) v += __shfl_xor(v, o);
    return v;
}
__device__ __forceinline__ void transpose_item(const float* W, int K, int N, bf16* WT, int row_off, const float* gain, LAS float* scr, int item, int lane) {
    const int nblk = N / 32, kb = item / nblk, nb = item % nblk, k0 = 64 * kb, n0 = 32 * nb;
#pragma unroll 8
    for (int i = 0; i < 32; ++i) { const int kk = 2 * i + (lane >> 5); const float g = gain ? gain[k0 + kk] : 1.f; scr[kk * 33 + (lane & 31)] = W[(size_t)(k0 + kk) * N + n0 + (lane & 31)] * g; }
    asm volatile("s_waitcnt lgkmcnt(0)" ::: "memory");
    const int c = lane & 7;
#pragma unroll
    for (int j = 0; j < 4; ++j) { const int n = (lane >> 3) + 8 * j; const LAS float* s = scr + (8 * c) * 33 + n;
        v4u o; o.x = pk2(s[0 * 33], s[1 * 33]); o.y = pk2(s[2 * 33], s[3 * 33]); o.z = pk2(s[4 * 33], s[5 * 33]); o.w = pk2(s[6 * 33], s[7 * 33]);
        *(v4u*)(WT + (size_t)(row_off + n0 + n) * K + k0 + 8 * c) = o; }
    asm volatile("s_waitcnt lgkmcnt(0)" ::: "memory");
}
struct TJob { const float* W; int K, N; bf16* WT; int row_off; const float* gain; };
__device__ __forceinline__ int tjob_items(const TJob& j) { return (j.K / 64) * (j.N / 32); }

__device__ __forceinline__ void sincos_red(double r, float& sn, float& cs_) {
    const double y = 0.5 * r, y2 = y * y;
    double s = -7.6471637318198164759e-13;
    s = s * y2 + 1.6059043836821614599e-10;
    s = s * y2 - 2.5052108385441718775e-8;
    s = s * y2 + 2.7557319223985890653e-6;
    s = s * y2 - 1.9841269841269841270e-4;
    s = s * y2 + 8.3333333333333333333e-3;
    s = s * y2 - 1.6666666666666666667e-1;
    s = s * y2 + 1.0; s *= y;
    double c = 4.7794773323873852974e-14;
    c = c * y2 - 1.1470745597729724714e-11;
    c = c * y2 + 2.0876756987868098979e-9;
    c = c * y2 - 2.7557319223985890653e-7;
    c = c * y2 + 2.4801587301587301587e-5;
    c = c * y2 - 1.3888888888888888889e-3;
    c = c * y2 + 4.1666666666666666667e-2;
    c = c * y2 - 0.5;
    c = c * y2 + 1.0;
    sn = (float)(2.0 * s * c); cs_ = (float)(1.0 - 2.0 * s * s);
}

__global__ void __launch_bounds__(NTHR) fwd_megakernel(Args args) {
    extern __shared__ __attribute__((aligned(16))) unsigned char lds[];
    cg::grid_group grid = cg::this_grid();
    const int G = gridDim.x, bx = blockIdx.x;
#define PHASE_IDS int tid_ = threadIdx.x; asm volatile("" : "+v"(tid_)); const int tid = tid_, lane = tid & 63, wave = __builtin_amdgcn_readfirstlane(tid >> 6); \
    const int vcu = (G % 8 == 0) ? (bx % 8) * (G / 8) + bx / 8 : bx; const int gw = vcu * NWAVES + wave, NGW = G * NWAVES; const int gt = bx * NTHR + tid, NGT = G * NTHR; \
    (void)lane; (void)gw; (void)NGW; (void)gt; (void)NGT; (void)vcu;
    unsigned char* ws = args.ws;
    LAS unsigned char* ldsl = (LAS unsigned char*)lds;
    const float* x = args.in[0];
    const float *attn_norm = args.in[2], *ffn_norm = args.in[3], *final_norm = args.in[4], *sc_w_in = args.in[5], *sc_conv_w = args.in[6], *sc_w_out = args.in[7];
    const float *kv_in_norm = args.in[8], *w_dkv = args.in[9], *kv_latent_norm = args.in[10], *w_kr = args.in[11], *w_uk = args.in[12], *w_uv = args.in[13];
    const float *w_dq = args.in[14], *q_latent_norm = args.in[15], *w_uq = args.in[16], *w_o = args.in[17];
    const float *ffn_w_up = args.in[18], *ffn_conv_w = args.in[19], *ffn_conv_b = args.in[20], *ffn_w_down = args.in[21];
    float* out = args.out;
    float* ssq = (float*)(ws + WS_SSQ); float* cst = (float*)(ws + WS_CS);
    bf16 *Win = (bf16*)(ws + WS_WIN), *Wout = (bf16*)(ws + WS_WOUT), *Wup = (bf16*)(ws + WS_WUP), *Wdn = (bf16*)(ws + WS_WDN), *Wcomb = (bf16*)(ws + WS_WCOMB),
         *Wukv = (bf16*)(ws + WS_WUKV), *Wuq = (bf16*)(ws + WS_WUQ), *Wo = (bf16*)(ws + WS_WO), *hb = (bf16*)(ws + WS_HB);

    for (int u = threadIdx.x; u < (LDS_BYTES - LDSX_OFF) / 4; u += NTHR) ((LAS unsigned*)(ldsl + LDSX_OFF))[u] = 0u;
    if (bx == 0) for (int u = threadIdx.x; u < XCD_BAR_WORDS; u += NTHR) ((unsigned*)(ws + WS_BAR))[u] = 0u;
    __syncthreads();
    for (int rep_ = 0; rep_ < PROBE_PRO; ++rep_) {
        PHASE_IDS
        LAS float* scr = (LAS float*)(ldsl + wave * 16384);
        int base = 0;
#define TJ(W_, K_, N_, WT_, RO_, G_) { const int n_ = ((K_) / 64) * ((N_) / 32); int it = gw; if (it < base) it += ((base - it + NGW - 1) / NGW) * NGW; \
            for (; it < base + n_; it += NGW) transpose_item(W_, K_, N_, WT_, RO_, G_, scr, it - base, lane); base += n_; }
        TJ(sc_w_in, D, NSC, Win, 0, attn_norm) TJ(sc_w_out, D, D, Wout, 0, nullptr) TJ(ffn_w_up, D, NUP, Wup, 0, ffn_norm) TJ(ffn_w_down, DFF, D, Wdn, 0, nullptr)
        TJ(w_dkv, D, KVL, Wcomb, 0, kv_in_norm) TJ(w_kr, D, 64, Wcomb, 256, kv_in_norm) TJ(w_dq, D, QL, Wcomb, 320, attn_norm + D)
        TJ(w_uk, KVL, D, Wukv, 0, nullptr) TJ(w_uv, KVL, D, Wukv, 1024, nullptr) TJ(w_uq, QL, NQ, Wuq, 0, nullptr) TJ(w_o, D, D, Wo, 0, nullptr)
        for (int i = gt; i < 64 * D / 8; i += NGT) *(v4u*)(Wcomb + (size_t)704 * D + (size_t)i * 8) = (v4u){0u, 0u, 0u, 0u};
        for (int m = gw; m < M; m += NGW) {
            const f32x4* xr = (const f32x4*)(x + (size_t)m * D) + lane; unsigned long long* o8 = (unsigned long long*)(hb + (size_t)m * D) + lane; float s = 0.f;
#pragma unroll
            for (int j = 0; j < 4; ++j) { const f32x4 v = xr[64 * j]; s += (v[0] * v[0] + v[1] * v[1]) + (v[2] * v[2] + v[3] * v[3]);
                o8[64 * j] = (unsigned long long)pk2(v[0], v[1]) | ((unsigned long long)pk2(v[2], v[3]) << 32); }
            s = wave_sum(s);
            if (lane < 16) ssq[(size_t)m * 16 + lane] = lane == 0 ? s : 0.f;
        }
        for (int i = gt; i < M * 32; i += NGT) { const int row = i >> 5, f = i & 31;
            double inv = 1.0; for (int k = 0; k < f; ++k) inv *= 0.74989420933245582730;
            const double ang = (double)args.pos[row] * inv;
            const double kq = __builtin_rint(ang * 0.15915494309189535);
            double r = ang - kq * 6.283185307179586; r -= kq * 2.4492935982947064e-16;
            float sn, cs_; sincos_red(r, sn, cs_);
            cst[(size_t)row * 64 + f] = cs_; cst[(size_t)row * 64 + 32 + f] = sn; }
    }
    grid.sync();
    const XcdBarrier xbar = xcd_barrier_post((unsigned*)(ws + WS_BAR), (volatile LAS unsigned*)(ldsl + LDSX_OFF));
    for (int rep_ = 0; rep_ < PROBE_SYNC; ++rep_) xcd_barrier(xbar);

#pragma nounroll
    for (int layer = 0; layer < 2; ++layer) {
        if (layer == 0) {
            { pg8::Gemm g{hb, Win, M, NSC, D}; pg8::StaticOrder S; S.init(M, NSC, G, bx);
              pg8::EpiBf16S E{(bf16*)(ws + BIG_SC), nullptr, 1 << 30, NSC, ssq};
              pg8::gemm_phase<pg8::EpiBf16S, pg8::StaticOrder, true, true>(ldsl, g, S, E); }
            xcd_barrier(xbar);
            for (int rep_ = 0; rep_ < PROBE_ELT; ++rep_) { PHASE_IDS const bf16* sc = (const bf16*)(ws + BIG_SC); bf16* mix = (bf16*)(ws + BIG_MIX);
              for (int it = gt; it < (M / 16) * (D / 8); it += NGT) { const int tb = it / (D / 8), cgp = it % (D / 8), t0 = tb * 16, c0 = cgp * 8;
                float w0[8], w1[8], w2[8], p1[8], p2[8];
#pragma unroll
                for (int e = 0; e < 8; ++e) { w0[e] = sc_conv_w[c0 + e]; w1[e] = sc_conv_w[D + c0 + e]; w2[e] = sc_conv_w[2 * D + c0 + e]; p1[e] = 0.f; p2[e] = 0.f; }
                if (t0 % SEQ != 0) {
                    const v4u c2 = *(const v4u*)(sc + (size_t)(t0 - 2) * NSC + D + c0), u2 = *(const v4u*)(sc + (size_t)(t0 - 2) * NSC + 2 * D + c0);
                    const v4u c1 = *(const v4u*)(sc + (size_t)(t0 - 1) * NSC + D + c0), u1 = *(const v4u*)(sc + (size_t)(t0 - 1) * NSC + 2 * D + c0);
#pragma unroll
                    for (int w = 0; w < 4; ++w) { p2[2 * w] = bflo(c2[w]) * bflo(u2[w]); p2[2 * w + 1] = bfhi(c2[w]) * bfhi(u2[w]); p1[2 * w] = bflo(c1[w]) * bflo(u1[w]); p1[2 * w + 1] = bfhi(c1[w]) * bfhi(u1[w]); }
                }
#pragma unroll 4
                for (int t = 0; t < 16; ++t) { const size_t ro = (size_t)(t0 + t) * NSC + c0;
                    const v4u bb = *(const v4u*)(sc + ro), cc = *(const v4u*)(sc + ro + D), uu = *(const v4u*)(sc + ro + 2 * D); float cu[8], y[8];
#pragma unroll
                    for (int w = 0; w < 4; ++w) { cu[2 * w] = bflo(cc[w]) * bflo(uu[w]); cu[2 * w + 1] = bfhi(cc[w]) * bfhi(uu[w]); }
#pragma unroll
                    for (int e = 0; e < 8; ++e) { y[e] = w0[e] * p2[e] + w1[e] * p1[e] + w2[e] * cu[e]; p2[e] = p1[e]; p1[e] = cu[e]; }
                    v4u o;
#pragma unroll
                    for (int w = 0; w < 4; ++w) o[w] = pk2(bflo(bb[w]) * y[2 * w], bfhi(bb[w]) * y[2 * w + 1]);
                    *(v4u*)(mix + (size_t)(t0 + t) * D + c0) = o; } } }
            xcd_barrier(xbar);
            { pg8::Gemm g{(const bf16*)(ws + BIG_MIX), Wout, M, D, D}; pg8::StaticOrder S; S.init(M, D, G, bx);
              pg8::EpiRes E{x, out, hb, ssq, D};
              pg8::gemm_phase<pg8::EpiRes, pg8::StaticOrder, true, true>(ldsl, g, S, E); }
            xcd_barrier(xbar);
        } else {
            { pg8::Gemm g{hb, Wcomb, M, NCOMB, D}; pg8::StaticOrder S; S.init(M, NCOMB, G, bx);
              pg8::EpiF32S E{(float*)(ws + BIG_COMB), NCOMB, ssq};
              pg8::gemm_phase<pg8::EpiF32S, pg8::StaticOrder, true, true>(ldsl, g, S, E); }
            xcd_barrier(xbar);
            { PHASE_IDS const float* comb = (const float*)(ws + BIG_COMB); bf16* ckv = (bf16*)(ws + HB_CKV); bf16* cq = (bf16*)(ws + HB_CQ); bf16* kr = (bf16*)(ws + HB_KR);
              for (int m = gw; m < M; m += NGW) { const float* row = comb + (size_t)m * NCOMB;
                { const f32x4 v = *((const f32x4*)row + lane); const float s = wave_sum((v[0] * v[0] + v[1] * v[1]) + (v[2] * v[2] + v[3] * v[3]));
                  const float r = __builtin_amdgcn_rsqf(s * (1.f / KVL) + 1e-6f); const f32x4 gn = *((const f32x4*)kv_latent_norm + lane);
                  v2u o; o.x = pk2(v[0] * r * gn[0], v[1] * r * gn[1]); o.y = pk2(v[2] * r * gn[2], v[3] * r * gn[3]); *((v2u*)(ckv + (size_t)m * KVL) + lane) = o; }
                { const int i = lane & 31; const float x1 = row[256 + i], x2 = row[288 + i], c = cst[(size_t)m * 64 + i], s = cst[(size_t)m * 64 + 32 + i];
                  const float o = lane < 32 ? x1 * c - x2 * s : x2 * c + x1 * s; kr[(size_t)m * 64 + lane] = (bf16)f2bf(o); }
                { f32x2 v[3]; float s = 0.f;
#pragma unroll
                  for (int j = 0; j < 3; ++j) { v[j] = *((const f32x2*)(row + 320 + j * 128) + lane); s += v[j][0] * v[j][0] + v[j][1] * v[j][1]; }
                  s = wave_sum(s); const float r = __builtin_amdgcn_rsqf(s * (1.f / QL) + 1e-6f);
#pragma unroll
                  for (int j = 0; j < 3; ++j) { const f32x2 gn = *((const f32x2*)(q_latent_norm + j * 128) + lane);
                    *((unsigned*)(cq + (size_t)m * QL + j * 128) + lane) = pk2(v[j][0] * r * gn[0], v[j][1] * r * gn[1]); } } }
              LAS float* scr = (LAS float*)(ldsl + wave * 16384);
              const TJob j0{ffn_w_up + (size_t)D * NUP, D, NUP, Wup, 0, ffn_norm + D}, j1{ffn_w_down + (size_t)DFF * D, DFF, D, Wdn, 0, nullptr};
              const int n0 = tjob_items(j0), n1 = tjob_items(j1);
              for (int it = gw; it < n0 + n1; it += NGW) { if (it < n0) transpose_item(j0.W, j0.K, j0.N, j0.WT, 0, j0.gain, scr, it, lane); else transpose_item(j1.W, j1.K, j1.N, j1.WT, 0, nullptr, scr, it - n0, lane); } }
            xcd_barrier(xbar);
            { pg8::Gemm g{(const bf16*)(ws + HB_CKV), Wukv, M, NKV, KVL}; pg8::StaticOrder S; S.init(M, NKV, G, bx);
              pg8::EpiBf16S E{(bf16*)(ws + BIG_KN), (bf16*)(ws + BIG_VV), 1024, 1024, nullptr};
              pg8::gemm_phase<pg8::EpiBf16S, pg8::StaticOrder, true, true>(ldsl, g, S, E); }
            { pg8::Gemm g{(const bf16*)(ws + HB_CQ), Wuq, M, NQ, QL}; pg8::StaticOrder S; S.init(M, NQ, G, bx);
              pg8::EpiBf16S E{(bf16*)(ws + BIG_Q), nullptr, 1 << 30, NQ, nullptr};
              pg8::gemm_phase<pg8::EpiBf16S, pg8::StaticOrder, true, true>(ldsl, g, S, E); }
            xcd_barrier(xbar);
            for (int rep_ = 0; rep_ < PROBE_ATT; ++rep_) { PHASE_IDS for (int p = vcu; p < 256; p += G) { const int bh = p >> 2, s4 = p & 3;
                att::attn_unit((const bf16*)(ws + BIG_Q), (const bf16*)(ws + BIG_KN), (const bf16*)(ws + HB_KR), (const bf16*)(ws + BIG_VV), cst, (bf16*)(ws + BIG_O), bh >> 3, bh & 7, 7 - s4, (char*)lds);
                att::attn_unit((const bf16*)(ws + BIG_Q), (const bf16*)(ws + BIG_KN), (const bf16*)(ws + HB_KR), (const bf16*)(ws + BIG_VV), cst, (bf16*)(ws + BIG_O), bh >> 3, bh & 7, s4, (char*)lds); } }
            xcd_barrier(xbar);
            { pg8::Gemm g{(const bf16*)(ws + BIG_O), Wo, M, D, D}; pg8::StaticOrder S; S.init(M, D, G, bx);
              pg8::EpiRes E{out, out, hb, ssq, D};
              pg8::gemm_phase<pg8::EpiRes, pg8::StaticOrder, true, true>(ldsl, g, S, E); }
            xcd_barrier(xbar);
        }
        { pg8::Gemm g{hb, Wup, M, NUP, D}; pg8::StaticOrder S; S.init(M, NUP, G, bx);
          pg8::EpiBf16S E{(bf16*)(ws + BIG_G), (bf16*)(ws + BIG_V), DFF, DFF, ssq};
          pg8::gemm_phase<pg8::EpiBf16S, pg8::StaticOrder, true, true>(ldsl, g, S, E); }
        xcd_barrier(xbar);
        { PHASE_IDS const bf16* gg = (const bf16*)(ws + BIG_G); bf16* vv = (bf16*)(ws + BIG_V); const float* cw = ffn_conv_w + (size_t)layer * 3 * DFF; const float* cb = ffn_conv_b + (size_t)layer * DFF;
          for (int it = gt; it < (M / 16) * (DFF / 8); it += NGT) { const int tb = it / (DFF / 8), cgp = it % (DFF / 8), t0 = tb * 16, c0 = cgp * 8;
            float w0[8], w1[8], w2[8], bs[8], p1[8], p2[8];
#pragma unroll
            for (int e = 0; e < 8; ++e) { w0[e] = cw[c0 + e]; w1[e] = cw[DFF + c0 + e]; w2[e] = cw[2 * DFF + c0 + e]; bs[e] = cb[c0 + e]; p1[e] = 0.f; p2[e] = 0.f; }
            if (t0 % SEQ != 0) { const v4u g2 = *(const v4u*)(gg + (size_t)(t0 - 2) * DFF + c0), g1 = *(const v4u*)(gg + (size_t)(t0 - 1) * DFF + c0);
#pragma unroll
                for (int w = 0; w < 4; ++w) { p2[2 * w] = bflo(g2[w]); p2[2 * w + 1] = bfhi(g2[w]); p1[2 * w] = bflo(g1[w]); p1[2 * w + 1] = bfhi(g1[w]); } }
#pragma unroll 4
            for (int t = 0; t < 16; ++t) { const size_t ro = (size_t)(t0 + t) * DFF + c0; const v4u g0 = *(const v4u*)(gg + ro), v0 = *(const v4u*)(vv + ro); float cu[8], y[8];
#pragma unroll
                for (int w = 0; w < 4; ++w) { cu[2 * w] = bflo(g0[w]); cu[2 * w + 1] = bfhi(g0[w]); }
#pragma unroll
                for (int e = 0; e < 8; ++e) { const float z = w0[e] * p2[e] + w1[e] * p1[e] + w2[e] * cu[e] + bs[e]; p2[e] = p1[e]; p1[e] = cu[e];
                    y[e] = z * __builtin_amdgcn_rcpf(1.f + __expf(-z)); }
                v4u o;
#pragma unroll
                for (int w = 0; w < 4; ++w) o[w] = pk2(y[2 * w] * bflo(v0[w]), y[2 * w + 1] * bfhi(v0[w]));
                *(v4u*)(vv + ro) = o; } } }
        xcd_barrier(xbar);
        { pg8::Gemm g{(const bf16*)(ws + BIG_V), Wdn, M, D, DFF}; pg8::StaticOrder S; S.init(M, D, G, bx);
          pg8::EpiRes E{out, out, hb, ssq, D};
          pg8::gemm_phase<pg8::EpiRes, pg8::StaticOrder, true, true>(ldsl, g, S, E); }
        xcd_barrier(xbar);
    }
    { PHASE_IDS
    for (int m = gw; m < M; m += NGW) { f32x4* xr = (f32x4*)(out + (size_t)m * D) + lane; f32x4 v[4]; float s = 0.f;
#pragma unroll
        for (int j = 0; j < 4; ++j) { v[j] = xr[64 * j]; s += (v[j][0] * v[j][0] + v[j][1] * v[j][1]) + (v[j][2] * v[j][2] + v[j][3] * v[j][3]); }
        const float r = __builtin_amdgcn_rsqf(wave_sum(s) * (1.f / D) + 1e-6f);
#pragma unroll
        for (int j = 0; j < 4; ++j) { const f32x4 gn = *((const f32x4*)final_norm + lane + 64 * j); xr[64 * j] = v[j] * r * gn; } } }
}

extern "C" void kernel_launch(void* const* d_in, const int* in_sizes, int n_in, void* d_out, int out_size, void* d_ws, size_t ws_size, hipStream_t stream) {
    static int grid_blocks = 0;
    if (grid_blocks == 0) {
        if (n_in != 22 || out_size != M * D || ws_size < WS_END) { fprintf(stderr, "kernel_launch: unexpected shapes: n_in %d out %d ws %zu (need %zu)\n", n_in, out_size, ws_size, (size_t)WS_END); grid_blocks = -1; return; }
        int dev = 0, cus = 0, per_cu = 0;
        hipGetDevice(&dev);
        hipDeviceGetAttribute(&cus, hipDeviceAttributeMultiprocessorCount, dev);
        if (hipFuncSetAttribute((const void*)fwd_megakernel, hipFuncAttributeMaxDynamicSharedMemorySize, LDS_BYTES) != hipSuccess) { fprintf(stderr, "kernel_launch: hipFuncSetAttribute failed\n"); grid_blocks = -1; return; }
        if (hipOccupancyMaxActiveBlocksPerMultiprocessor(&per_cu, (const void*)fwd_megakernel, NTHR, LDS_BYTES) != hipSuccess || per_cu < 1) { fprintf(stderr, "kernel_launch: occupancy query failed (%d)\n", per_cu); (void)hipGetLastError(); grid_blocks = -1; return; }
        grid_blocks = cus * per_cu;
    }
    if (grid_blocks < 0) return;
    Args a{};
    for (int i = 0; i < 22; ++i) a.in[i] = (const float*)d_in[i];
    a.pos = (const int*)d_in[1]; a.out = (float*)d_out; a.ws = (unsigned char*)d_ws;
    void* kargs[] = {&a};
    hipError_t e = hipLaunchCooperativeKernel((const void*)fwd_megakernel, dim3(grid_blocks), dim3(NTHR), kargs, LDS_BYTES, stream);
    if (e != hipSuccess) fprintf(stderr, "cooperative launch failed: %s (grid %d)\n", hipGetErrorString(e), grid_blocks);
}
```

```cpp
#include <hip/hip_runtime.h>
#include <hip/hip_cooperative_groups.h>
#include <cstdio>
#include <cstdint>
namespace pg8 {
#define PG8_LAS __attribute__((address_space(3)))
typedef unsigned short bf16_t;
typedef short bf16x8 __attribute__((ext_vector_type(8)));
typedef float f32x4 __attribute__((ext_vector_type(4)));
typedef unsigned u32x4 __attribute__((ext_vector_type(4)));
constexpr int BM = 256, BK = 64, HALF = 128, HTB = HALF * BK * 2  , STAGE_BYTES = 8 * HTB, NXCD = 8, WGM = 8;

__host__ __device__ __forceinline__ int lds_byte(int r, int c) { const int st = (r >> 4) * 2 + (c >> 5), rr = r & 15, cc = c & 31, ob = rr * 64 + cc * 2; return st * 1024 + (ob ^ (((ob >> 9) & 1) << 5)); }
__host__ __device__ __forceinline__ void stage_rc(int b, int& R, int& C) { const int st = b / 1024, sb = b % 1024, swz = sb ^ (((sb >> 9) & 1) << 5); R = (st >> 1) * 16 + swz / 64; C = (st & 1) * 32 + (swz % 64) / 2; }
__host__ __device__ __forceinline__ int perm32(int rho) { const int n = rho >> 4, i = rho & 15; return 8 * (i >> 2) + 4 * n + (i & 3); }

struct Unit { int pm, pn; };
struct Gemm { const bf16_t* A; const bf16_t* Bt; int M, N, K; };

struct StaticOrder {
    int nM, nN, nwg, G, c;
    __host__ __device__ void init(int M, int N, int G_, int c_) { nM = M / BM; nN = N / BM; nwg = nM * nN; G = G_; c = c_; }
    __host__ __device__ bool next(int i, Unit& u) const {
        const long L = (long)i * G + c; if (L >= nwg) return false;
        int wgid = (int)L; { const int q = nwg / NXCD, r = nwg % NXCD, xcd = wgid % NXCD, off = wgid / NXCD; wgid = (xcd < r ? xcd * (q + 1) : r * (q + 1) + (xcd - r) * q) + off; }
        const int nig = WGM * nN, gid = wgid / nig, fm = gid * WGM, gsz = (nM - fm) < WGM ? (nM - fm) : WGM;
        u.pm = fm + ((wgid % nig) % gsz); u.pn = (wgid % nig) / gsz; return true;
    }
    __device__ __forceinline__ void a_ready(const Unit&) const {}
    __device__ __forceinline__ void done(const Unit&) const {}
};
__device__ __forceinline__ unsigned cvt_pk_bf16(float lo, float hi) { unsigned r; asm volatile("v_cvt_pk_bf16_f32 %0, %1, %2" : "=v"(r) : "v"(lo), "v"(hi)); return r; }
typedef float f32x2 __attribute__((ext_vector_type(2)));
__device__ __forceinline__ float row_rstd(const float* ssq, int row) {
    const f32x4* p = (const f32x4*)(ssq + (size_t)row * 16);
    const f32x4 a = p[0], b = p[1], c = p[2], d = p[3];
    const f32x4 s = (a + b) + (c + d);
    return __builtin_amdgcn_rsqf(((s[0] + s[1]) + (s[2] + s[3])) * (1.0f / 1024.0f) + 1e-6f);
}
struct EpiBf16S {
    static constexpr bool PERM = true, AFTER_DRAIN = false;
    bf16_t* O0; bf16_t* O1; int split_cols; int ldc; const float* ssq;
    __device__ __forceinline__ void operator()(const f32x4 (&acc)[2][2][4][2], const Unit& u, int wr, int wc, int fr, int fq) const {
        const int row0 = u.pm * BM + wr * 64 + fr; int colt = u.pn * BM; bf16_t* base = O0;
        if (colt >= split_cols) { base = O1; colt -= split_cols; }
        const int col0 = colt + wc * 32 + 8 * fq;
#pragma unroll
        for (int ai = 0; ai < 2; ++ai)
#pragma unroll
            for (int m = 0; m < 4; ++m) { const int row = row0 + ai * HALF + m * 16; const float sc = ssq ? row_rstd(ssq, row) : 1.f;
                bf16_t* rowp = base + (size_t)row * ldc + col0;
#pragma unroll
                for (int bj = 0; bj < 2; ++bj) { const f32x4 v0 = acc[ai][bj][m][0] * sc, v1 = acc[ai][bj][m][1] * sc;
                    u32x4 w; w.x = cvt_pk_bf16(v0[0], v0[1]); w.y = cvt_pk_bf16(v0[2], v0[3]); w.z = cvt_pk_bf16(v1[0], v1[1]); w.w = cvt_pk_bf16(v1[2], v1[3]);
                    *(u32x4*)(rowp + bj * HALF) = w; } }
    }
};
struct EpiF32S {
    static constexpr bool PERM = false, AFTER_DRAIN = false;
    float* O; int ldc; const float* ssq;
    __device__ __forceinline__ void operator()(const f32x4 (&acc)[2][2][4][2], const Unit& u, int wr, int wc, int fr, int fq) const {
        const int row0 = u.pm * BM + wr * 64 + fr; const int col0 = u.pn * BM + wc * 32 + 4 * fq;
#pragma unroll
        for (int ai = 0; ai < 2; ++ai)
#pragma unroll
            for (int m = 0; m < 4; ++m) { const int row = row0 + ai * HALF + m * 16; const float sc = row_rstd(ssq, row);
                float* rowp = O + (size_t)row * ldc + col0;
#pragma unroll
                for (int bj = 0; bj < 2; ++bj)
#pragma unroll
                    for (int n = 0; n < 2; ++n) *(f32x4*)(rowp + bj * HALF + n * 16) = acc[ai][bj][m][n] * sc; }
    }
};
struct EpiRes {
    static constexpr bool PERM = false, AFTER_DRAIN = false;
    const float* base; float* out; bf16_t* hb; float* ssq; int ldc;
    __device__ __forceinline__ void operator()(const f32x4 (&acc)[2][2][4][2], const Unit& u, int wr, int wc, int fr, int fq) const {
        typedef unsigned u32x2v __attribute__((ext_vector_type(2)));
        const int row0 = u.pm * BM + wr * 64 + fr; const int col0 = u.pn * BM + wc * 32 + 4 * fq;
#pragma unroll
        for (int ai = 0; ai < 2; ++ai)
#pragma unroll
            for (int m = 0; m < 4; ++m) { const int row = row0 + ai * HALF + m * 16; const size_t off = (size_t)row * ldc + col0; float s = 0.f;
#pragma unroll
                for (int bj = 0; bj < 2; ++bj)
#pragma unroll
                    for (int n = 0; n < 2; ++n) { const f32x4 h = *(const f32x4*)(base + off + bj * HALF + n * 16) + acc[ai][bj][m][n];
                        *(f32x4*)(out + off + bj * HALF + n * 16) = h;
                        u32x2v w; w.x = cvt_pk_bf16(h[0], h[1]); w.y = cvt_pk_bf16(h[2], h[3]); *(u32x2v*)(hb + off + bj * HALF + n * 16) = w;
                        s += (h[0] * h[0] + h[1] * h[1]) + (h[2] * h[2] + h[3] * h[3]); }
                s += __shfl_xor(s, 16); s += __shfl_xor(s, 32);
                if (fq == 0) ssq[(size_t)row * 16 + u.pn * 4 + wc] = s;
                asm volatile("" ::: "memory"); }
    }
};
__device__ __forceinline__ float dpp_ror1(float v) { return __int_as_float(__builtin_amdgcn_update_dpp(0, __float_as_int(v), 0x121, 0xF, 0xF, false)); }
__device__ __forceinline__ float dpp_ror2(float v) { return __int_as_float(__builtin_amdgcn_update_dpp(0, __float_as_int(v), 0x122, 0xF, 0xF, false)); }
struct EpiGate {
    static constexpr bool PERM = true, AFTER_DRAIN = false;
    bf16_t* act; const float* ssq; const float* cw; const float* cb; float* halo; float* headg; float* headv; PG8_LAS float* X;
    __device__ __forceinline__ void operator()(const f32x4 (&acc)[2][2][4][2], const Unit& u, int wr, int wc, int fr, int fq) const {
        constexpr int FF = 2816;
        const int row0 = u.pm * BM + wr * 64 + fr, ch0 = u.pn * 128 + wc * 32 + 8 * fq;
#pragma unroll
        for (int ai = 0; ai < 2; ++ai) { const int row = row0 + ai * HALF + 48; const float sc = row_rstd(ssq, row);
            if (fr >= 14) { PG8_LAS float* xp = X + ((ai * 2 + wr) * 4 + wc) * 64 + (fr - 14) * 32 + 8 * fq;
                *(PG8_LAS f32x4*)xp = acc[ai][0][3][0] * sc; *(PG8_LAS f32x4*)(xp + 4) = acc[ai][0][3][1] * sc;
                if (ai == 1 && wr == 1) { float* hp = halo + ((size_t)u.pm * 2 + (fr - 14)) * FF + ch0; *(f32x4*)hp = acc[1][0][3][0] * sc; *(f32x4*)(hp + 4) = acc[1][0][3][1] * sc; } } }
        float w0[8], w1[8], w2[8], bs[8];
        { const f32x4 a0 = *(const f32x4*)(cw + ch0), a1 = *(const f32x4*)(cw + ch0 + 4), b0 = *(const f32x4*)(cw + FF + ch0), b1 = *(const f32x4*)(cw + FF + ch0 + 4);
          const f32x4 c0 = *(const f32x4*)(cw + 2 * FF + ch0), c1 = *(const f32x4*)(cw + 2 * FF + ch0 + 4), d0 = *(const f32x4*)(cb + ch0), d1 = *(const f32x4*)(cb + ch0 + 4);
#pragma unroll
          for (int e = 0; e < 4; ++e) { w0[e] = a0[e]; w0[4 + e] = a1[e]; w1[e] = b0[e]; w1[4 + e] = b1[e]; w2[e] = c0[e]; w2[4 + e] = c1[e]; bs[e] = d0[e]; bs[4 + e] = d1[e]; } }
        asm volatile("s_waitcnt lgkmcnt(0)" ::: "memory"); __builtin_amdgcn_s_barrier(); asm volatile("" ::: "memory");
        const bool seq_start = (u.pm & 7) == 0;
#pragma unroll
        for (int ai = 0; ai < 2; ++ai) {
            float prev[8];
            if (ai == 0 && wr == 0) {
#pragma unroll
                for (int e = 0; e < 8; ++e) prev[e] = 0.f;
            } else { const int pa = wr == 1 ? ai : 0, pw = wr == 1 ? 0 : 1; const PG8_LAS float* xp = X + ((pa * 2 + pw) * 4 + wc) * 64 + (fr == 14 ? 0 : 32) + 8 * fq;
                const f32x4 q0 = *(const PG8_LAS f32x4*)xp, q1 = *(const PG8_LAS f32x4*)(xp + 4);
#pragma unroll
                for (int e = 0; e < 4; ++e) { prev[e] = q0[e]; prev[4 + e] = q1[e]; } }
#pragma unroll
            for (int m = 0; m < 4; ++m) { const int row = row0 + ai * HALF + m * 16; const float sc = row_rstd(ssq, row);
                float cur[8], vv[8], y[8];
#pragma unroll
                for (int e = 0; e < 4; ++e) { cur[e] = acc[ai][0][m][0][e] * sc; cur[4 + e] = acc[ai][0][m][1][e] * sc; vv[e] = acc[ai][1][m][0][e] * sc; vv[4 + e] = acc[ai][1][m][1][e] * sc; }
#pragma unroll
                for (int e = 0; e < 8; ++e) { const float c1 = dpp_ror1(cur[e]), c2 = dpp_ror2(cur[e]), p1 = dpp_ror1(prev[e]), p2 = dpp_ror2(prev[e]);
                    const float g1 = fr >= 1 ? c1 : p1, g2 = fr >= 2 ? c2 : p2;
                    const float z = w0[e] * g2 + w1[e] * g1 + w2[e] * cur[e] + bs[e];
                    y[e] = z * __builtin_amdgcn_rcpf(1.f + __builtin_amdgcn_exp2f(-1.4426950408889634f * z)) * vv[e]; }
                const bool top = (ai == 0 && wr == 0 && m == 0 && !seq_start && fr < 2);
                if (top) { float* hg = headg + ((size_t)u.pm * 2 + fr) * FF + ch0; float* hv = headv + ((size_t)u.pm * 2 + fr) * FF + ch0;
                    *(f32x4*)hg = (f32x4){cur[0], cur[1], cur[2], cur[3]}; *(f32x4*)(hg + 4) = (f32x4){cur[4], cur[5], cur[6], cur[7]};
                    *(f32x4*)hv = (f32x4){vv[0], vv[1], vv[2], vv[3]}; *(f32x4*)(hv + 4) = (f32x4){vv[4], vv[5], vv[6], vv[7]}; }
                else { u32x4 w; w.x = cvt_pk_bf16(y[0], y[1]); w.y = cvt_pk_bf16(y[2], y[3]); w.z = cvt_pk_bf16(y[4], y[5]); w.w = cvt_pk_bf16(y[6], y[7]);
                    *(u32x4*)(act + (size_t)row * FF + ch0) = w; }
#pragma unroll
                for (int e = 0; e < 8; ++e) prev[e] = cur[e]; }
        }
    }
};
template <class Epi, class Sched, bool ALIGN_EPI = false, bool SP2 = false>
__device__ __forceinline__ void gemm_phase(PG8_LAS unsigned char* lds, const Gemm g, const Sched& S, const Epi& E) {
    int tid_ = threadIdx.x; asm volatile("" : "+v"(tid_));
    const int tid = tid_, wid = __builtin_amdgcn_readfirstlane(tid >> 6), lane = tid & 63, wr = wid >> 2, wc = wid & 3, fr = lane & 15, fq = lane >> 4;
    const int K = g.K, nt = K / BK;
    unsigned voffA[2], voffB[2];
#pragma unroll
    for (int i = 0; i < 2; ++i) { int R, C; stage_rc(tid * 16 + i * 8192, R, C); const int Rb = Epi::PERM ? ((R & ~31) + perm32(R & 31)) : R;
        voffA[i] = (unsigned)(R * K + C) * 2u; voffB[i] = (unsigned)(Rb * K + C) * 2u; }
    const size_t kstep = (size_t)(BK * 2);
    const size_t hstep = (size_t)HALF * K * 2;
    const size_t tstep = 2 * hstep;
    const unsigned ldsw = (unsigned)wid * 1024u;
    const int aoff = lds_byte(wr * 64 + fr, fq * 8), boff = lds_byte(wc * 32 + fr, fq * 8);
#define PG8_SA(b, h) (((b) * 2 + (h)) * HTB)
#define PG8_SB(b, h) ((4 + (b) * 2 + (h)) * HTB)
#define PG8_STAGE(bufoff, gbase, voff) do { _Pragma("unroll") for (int _i = 0; _i < 2; ++_i) \
        __builtin_amdgcn_global_load_lds((const unsigned*)((const char*)(gbase) + (voff)[_i]), (PG8_LAS unsigned*)(lds + (bufoff) + ldsw + _i * 8192), 16, 0, 0); } while (0)
#define PG8_LDA(dst, b, h) do { _Pragma("unroll") for (int m = 0; m < 4; ++m) _Pragma("unroll") for (int k = 0; k < 2; ++k) dst[m][k] = *(const PG8_LAS bf16x8*)(lds + PG8_SA(b, h) + aoff + m * 2048 + k * 1024); } while (0)
#define PG8_LDB(dst, b, h) do { _Pragma("unroll") for (int n = 0; n < 2; ++n) _Pragma("unroll") for (int k = 0; k < 2; ++k) dst[n][k] = *(const PG8_LAS bf16x8*)(lds + PG8_SB(b, h) + boff + n * 2048 + k * 1024); } while (0)
#define PG8_MMA(ai, bj, At, Bt) do { __builtin_amdgcn_s_setprio(1); _Pragma("unroll") for (int m = 0; m < 4; ++m) _Pragma("unroll") for (int n = 0; n < 2; ++n) _Pragma("unroll") for (int k = 0; k < 2; ++k) \
        acc[ai][bj][m][n] = __builtin_amdgcn_mfma_f32_16x16x32_bf16(Bt[n][k], At[m][k], acc[ai][bj][m][n], 0, 0, 0); __builtin_amdgcn_s_setprio(0); } while (0)
#define PG8_WAIT_V(n) asm volatile("s_waitcnt vmcnt(" #n ")" ::: "memory")
#define PG8_WAIT_L(n) asm volatile("s_waitcnt lgkmcnt(" #n ")" ::: "memory")
#define PG8_BAR __builtin_amdgcn_s_barrier()
#define PG8_SCHED __builtin_amdgcn_sched_barrier(0)
    Unit cur, nxt; int ui = 0;
    if (!S.next(0, cur)) return;
    f32x4 acc[2][2][4][2];
#pragma unroll
    for (int a = 0; a < 2; ++a)
#pragma unroll
        for (int b = 0; b < 2; ++b)
#pragma unroll
            for (int m = 0; m < 4; ++m)
#pragma unroll
                for (int n = 0; n < 2; ++n) acc[a][b][m][n] = (f32x4){0.f, 0.f, 0.f, 0.f};
    bf16x8 At[4][2], B0[2][2], B1[2][2];
    const char* cA = (const char*)g.A + (size_t)cur.pm * tstep; const char* cB = (const char*)g.Bt + (size_t)cur.pn * tstep;
    S.a_ready(cur);
    if constexpr (SP2) {
        PG8_STAGE(PG8_SB(0, 0), cB, voffB); PG8_STAGE(PG8_SB(0, 1), cB + hstep, voffB); PG8_STAGE(PG8_SA(0, 0), cA, voffA); PG8_STAGE(PG8_SA(0, 1), cA + hstep, voffA);
        if (wr == 1) PG8_BAR;
        PG8_WAIT_V(2); PG8_BAR;
        PG8_STAGE(PG8_SB(1, 0), cB + kstep, voffB); PG8_STAGE(PG8_SA(1, 0), cA + kstep, voffA); PG8_STAGE(PG8_SB(1, 1), cB + hstep + kstep, voffB);
        PG8_WAIT_V(6); PG8_BAR;
    } else {
        PG8_STAGE(PG8_SB(0, 0), cB, voffB); PG8_STAGE(PG8_SA(0, 0), cA, voffA); PG8_STAGE(PG8_SB(0, 1), cB + hstep, voffB); PG8_STAGE(PG8_SA(0, 1), cA + hstep, voffA);
        if (wr == 1) PG8_BAR;
        PG8_WAIT_V(4); PG8_BAR;
        PG8_STAGE(PG8_SB(1, 0), cB + kstep, voffB); PG8_STAGE(PG8_SA(1, 0), cA + kstep, voffA); PG8_STAGE(PG8_SB(1, 1), cB + hstep + kstep, voffB);
        PG8_WAIT_V(6); PG8_BAR;
    }
    for (;;) {
        const bool has_next = S.next(ui + 1, nxt);
        const char* nA = has_next ? (const char*)g.A + (size_t)nxt.pm * tstep : cA; const char* nB = has_next ? (const char*)g.Bt + (size_t)nxt.pn * tstep : cB;
        for (int t = 0; t < nt; t += 2) {
            const bool last = (t == nt - 2);
            const char* a1 = cA + (size_t)(t + 1) * kstep;
            const char* a2 = last ? nA : cA + (size_t)(t + 2) * kstep; const char* b2 = last ? nB : cB + (size_t)(t + 2) * kstep;
            const char* a3 = a2 + kstep; const char* b3 = b2 + kstep;
            if (last && has_next) S.a_ready(nxt);
            if constexpr (SP2) {
            PG8_LDB(B0, 0, 0); PG8_LDB(B1, 0, 1); PG8_SCHED; PG8_LDA(At, 0, 0); PG8_STAGE(PG8_SA(1, 1), a1 + hstep, voffA);
            PG8_WAIT_V(8); PG8_WAIT_L(0); PG8_BAR; PG8_MMA(0, 0, At, B0); PG8_MMA(0, 1, At, B1); PG8_BAR; PG8_SCHED;
            PG8_LDA(At, 0, 1); PG8_STAGE(PG8_SB(0, 0), b2, voffB); PG8_STAGE(PG8_SB(0, 1), b2 + hstep, voffB); PG8_STAGE(PG8_SA(0, 0), a2, voffA);
            PG8_WAIT_V(8); PG8_WAIT_L(0); PG8_BAR; PG8_MMA(1, 0, At, B0); PG8_MMA(1, 1, At, B1); PG8_BAR; PG8_SCHED;
            PG8_LDB(B0, 1, 0); PG8_LDB(B1, 1, 1); PG8_SCHED; PG8_LDA(At, 1, 0); PG8_STAGE(PG8_SA(0, 1), a2 + hstep, voffA);
            PG8_WAIT_V(8); PG8_WAIT_L(0); PG8_BAR; PG8_MMA(0, 0, At, B0); PG8_MMA(0, 1, At, B1); PG8_BAR; PG8_SCHED;
            PG8_LDA(At, 1, 1); PG8_STAGE(PG8_SB(1, 0), b3, voffB); PG8_STAGE(PG8_SB(1, 1), b3 + hstep, voffB); PG8_STAGE(PG8_SA(1, 0), a3, voffA);
            PG8_WAIT_V(8); PG8_WAIT_L(0); PG8_BAR; PG8_MMA(1, 0, At, B0); PG8_MMA(1, 1, At, B1); PG8_BAR; PG8_SCHED;
            } else {
            PG8_LDB(B0, 0, 0); PG8_SCHED; PG8_LDA(At, 0, 0); PG8_STAGE(PG8_SA(1, 1), a1 + hstep, voffA);
            PG8_WAIT_L(8); PG8_BAR; PG8_WAIT_L(0); PG8_MMA(0, 0, At, B0); PG8_BAR; PG8_SCHED;
            PG8_LDB(B1, 0, 1); PG8_STAGE(PG8_SB(0, 0), b2, voffB);
            PG8_BAR; PG8_WAIT_L(0); PG8_MMA(0, 1, At, B1); PG8_BAR;
            PG8_LDA(At, 0, 1); PG8_STAGE(PG8_SA(0, 0), a2, voffA);
            PG8_BAR; PG8_WAIT_L(0); PG8_MMA(1, 0, At, B0); PG8_BAR; PG8_SCHED;
            PG8_STAGE(PG8_SB(0, 1), b2 + hstep, voffB);
            PG8_WAIT_V(6); PG8_BAR; PG8_MMA(1, 1, At, B1); PG8_BAR;
            PG8_LDB(B0, 1, 0); PG8_SCHED; PG8_LDA(At, 1, 0); PG8_STAGE(PG8_SA(0, 1), a2 + hstep, voffA);
            PG8_WAIT_L(8); PG8_BAR; PG8_WAIT_L(0); PG8_MMA(0, 0, At, B0); PG8_BAR; PG8_SCHED;
            PG8_LDB(B1, 1, 1); PG8_STAGE(PG8_SB(1, 0), b3, voffB);
            PG8_BAR; PG8_WAIT_L(0); PG8_MMA(0, 1, At, B1); PG8_BAR;
            PG8_LDA(At, 1, 1); PG8_STAGE(PG8_SA(1, 0), a3, voffA);
            PG8_BAR; PG8_WAIT_L(0); PG8_MMA(1, 0, At, B0); PG8_BAR; PG8_SCHED;
            PG8_STAGE(PG8_SB(1, 1), b3 + hstep, voffB);
            PG8_WAIT_V(6); PG8_BAR; PG8_MMA(1, 1, At, B1); PG8_BAR;
            }
        }
        if constexpr (ALIGN_EPI) { if (wr == 0) PG8_BAR; }
        if constexpr (!Epi::AFTER_DRAIN) { E(acc, cur, wr, wc, fr, fq); S.done(cur); }
        if (!has_next) break;
#pragma unroll
        for (int a = 0; a < 2; ++a)
#pragma unroll
            for (int b = 0; b < 2; ++b)
#pragma unroll
                for (int m = 0; m < 4; ++m)
#pragma unroll
                    for (int n = 0; n < 2; ++n) acc[a][b][m][n] = (f32x4){0.f, 0.f, 0.f, 0.f};
        cur = nxt; cA = nA; cB = nB; ++ui;
        if constexpr (ALIGN_EPI) { if (wr == 1) PG8_BAR; }
    }
    PG8_WAIT_V(0);
    if constexpr (!ALIGN_EPI) { if (wr == 0) PG8_BAR; }
    PG8_BAR;
    if constexpr (Epi::AFTER_DRAIN) { E.fused(acc, cur, wr, wc, fr, fq, lds, wid, lane); S.done(cur); }
#undef PG8_SA
#undef PG8_SB
#undef PG8_STAGE
#undef PG8_LDA
#undef PG8_LDB
#undef PG8_MMA
#undef PG8_WAIT_V
#undef PG8_WAIT_L
#undef PG8_BAR
#undef PG8_SCHED
}
}

namespace att {
using bf16x8 = __attribute__((ext_vector_type(8))) short;
using s16x4  = __attribute__((ext_vector_type(4))) short;
using f32x16 = __attribute__((ext_vector_type(16))) float;
using f32x4  = __attribute__((ext_vector_type(4))) float;
using u32x4  = __attribute__((ext_vector_type(4))) unsigned;
constexpr float SCALE = 0.07216878364870322f;
constexpr float THR = 8.f;
constexpr int SHM_V = 64 * 128 * 2, SHM_KN = 64 * 128 * 2, SHM_KR = 64 * 64 * 2;
constexpr int OFF_V = 0, OFF_KN = 2 * SHM_V, OFF_KR = OFF_KN + 2 * SHM_KN, OFF_WS = OFF_KR + 2 * SHM_KR, LDS_BYTES = OFF_WS + 8 * 64 * 4;
#define KSWZ(row, colB) ((row) * 256 + ((colB) ^ (((row) & 7) << 4)))
#define KRSWZ(row, colB) ((row) * 128 + ((colB) ^ (((row) & 7) << 4)))
#define SBAR() __builtin_amdgcn_sched_barrier(0)
__device__ __forceinline__ int crow(int r, int hi) { return (r & 3) + 8 * (r >> 2) + 4 * hi; }
__device__ __forceinline__ unsigned cvtpk(float lo, float hi) { unsigned r; asm volatile("v_cvt_pk_bf16_f32 %0, %1, %2" : "=v"(r) : "v"(lo), "v"(hi)); return r; }
__device__ __forceinline__ float bf_lo(unsigned w) { return __uint_as_float(w << 16); }
__device__ __forceinline__ float bf_hi(unsigned w) { return __uint_as_float(w & 0xffff0000u); }

__device__ __forceinline__ void partialSM(f32x16& p0, f32x16& p1, float& m_reg, float& alpha) {
  constexpr float C = SCALE * 1.4426950408889634f;
  float pmax = p0[0];
#pragma unroll
  for (int r = 1; r < 16; ++r) pmax = fmaxf(pmax, p0[r]);
#pragma unroll
  for (int r = 0; r < 16; ++r) pmax = fmaxf(pmax, p1[r]);
  { auto rr = __builtin_amdgcn_permlane32_swap(__float_as_uint(pmax), __float_as_uint(pmax), false, false);
    pmax = fmaxf(__uint_as_float(rr[0]), __uint_as_float(rr[1])); }
  float mn;
  if (__builtin_expect(__all(pmax - m_reg <= THR / SCALE), 1)) { mn = m_reg; alpha = 1.f; }
  else { mn = fmaxf(m_reg, pmax); alpha = __builtin_amdgcn_exp2f((m_reg - mn) * C); m_reg = mn; }
  const float mnC = -mn * C;
#pragma unroll
  for (int r = 0; r < 16; ++r) p0[r] = __builtin_amdgcn_exp2f(fmaf(p0[r], C, mnC));
#pragma unroll
  for (int r = 0; r < 16; ++r) p1[r] = __builtin_amdgcn_exp2f(fmaf(p1[r], C, mnC));
}
__device__ __forceinline__ void finishSM(f32x16& p0, f32x16& p1, float alpha, float& l_reg, bf16x8& pa0, bf16x8& pa1, bf16x8& pa2, bf16x8& pa3) {
  float ps = 0;
#pragma unroll
  for (int r = 0; r < 16; ++r) ps += p0[r];
#pragma unroll
  for (int r = 0; r < 16; ++r) ps += p1[r];
  { auto rr = __builtin_amdgcn_permlane32_swap(__float_as_uint(ps), __float_as_uint(ps), false, false);
    ps = __uint_as_float(rr[0]) + __uint_as_float(rr[1]); }
  l_reg = l_reg * alpha + ps;
#define PK4(P, BASE, OUT) do { unsigned a0 = cvtpk(P[BASE + 0], P[BASE + 1]), a1 = cvtpk(P[BASE + 2], P[BASE + 3]);   \
    unsigned b0 = cvtpk(P[BASE + 4], P[BASE + 5]), b1 = cvtpk(P[BASE + 6], P[BASE + 7]);                              \
    auto r0 = __builtin_amdgcn_permlane32_swap(a0, b0, false, false); auto r1 = __builtin_amdgcn_permlane32_swap(a1, b1, false, false); \
    u32x4 w = {r0[0], r1[0], r0[1], r1[1]}; OUT = *reinterpret_cast<bf16x8*>(&w); } while (0)
  PK4(p0, 0, pa0); PK4(p0, 8, pa1); PK4(p1, 0, pa2); PK4(p1, 8, pa3);
#undef PK4
}
__device__ __forceinline__ void qkt(f32x16& p0, f32x16& p1, const char* Kn, const char* Kr, const bf16x8* qr, int r32, int hi) {
  p0 = f32x16{}; p1 = f32x16{};
#pragma unroll
  for (int d0 = 0; d0 < 8; ++d0) { const int cb = (d0 * 16 + hi * 8) * 2;
    const bf16x8 b0 = *reinterpret_cast<const bf16x8*>(Kn + KSWZ(r32, cb));
    const bf16x8 b1 = *reinterpret_cast<const bf16x8*>(Kn + KSWZ(32 + r32, cb));
    p0 = __builtin_amdgcn_mfma_f32_32x32x16_bf16(b0, qr[d0], p0, 0, 0, 0);
    p1 = __builtin_amdgcn_mfma_f32_32x32x16_bf16(b1, qr[d0], p1, 0, 0, 0); }
#pragma unroll
  for (int d0 = 0; d0 < 4; ++d0) { const int cb = (d0 * 16 + hi * 8) * 2;
    const bf16x8 b0 = *reinterpret_cast<const bf16x8*>(Kr + KRSWZ(r32, cb));
    const bf16x8 b1 = *reinterpret_cast<const bf16x8*>(Kr + KRSWZ(32 + r32, cb));
    p0 = __builtin_amdgcn_mfma_f32_32x32x16_bf16(b0, qr[8 + d0], p0, 0, 0, 0);
    p1 = __builtin_amdgcn_mfma_f32_32x32x16_bf16(b1, qr[8 + d0], p1, 0, 0, 0); }
}
__device__ __forceinline__ int v_st(int k, int c) { const int kk = (k & ~0xC) | ((k & 4) << 1) | ((k & 8) >> 1); return ((kk >> 3) * 4 + (c >> 5)) * 512 + ((kk & 7) * 32 + (c & 31)) * 2; }
__device__ __forceinline__ int v_rd_base(int lane) { return ((lane & 3) << 3) | (((lane >> 2) & 3) << 6) | (((lane >> 4) & 1) << 5) | (((lane >> 5) & 1) << 8); }
constexpr int v_rd_off(int d0, int ks, int half) { return d0 * 512 + ks * 4096 + half * 2048; }
template <int OFF> __device__ __forceinline__ s16x4 tr_read(int vb) {
  s16x4 r; asm volatile("ds_read_b64_tr_b16 %0, %1 offset:%2" : "=&v"(r) : "v"(vb), "i"(OFF) : "memory"); return r;
}
template <int D0> __device__ __forceinline__ void pv_one(f32x16& od, int vb, bf16x8 pa0, bf16x8 pa1, bf16x8 pa2, bf16x8 pa3) {
  const s16x4 l0 = tr_read<v_rd_off(D0, 0, 0)>(vb), h0 = tr_read<v_rd_off(D0, 0, 1)>(vb), l1 = tr_read<v_rd_off(D0, 1, 0)>(vb), h1 = tr_read<v_rd_off(D0, 1, 1)>(vb);
  const s16x4 l2 = tr_read<v_rd_off(D0, 2, 0)>(vb), h2 = tr_read<v_rd_off(D0, 2, 1)>(vb), l3 = tr_read<v_rd_off(D0, 3, 0)>(vb), h3 = tr_read<v_rd_off(D0, 3, 1)>(vb);
  asm volatile("s_waitcnt lgkmcnt(0)" ::: "memory"); SBAR();
#define PK(L, H) (bf16x8){L[0], L[1], L[2], L[3], H[0], H[1], H[2], H[3]}
  od = __builtin_amdgcn_mfma_f32_32x32x16_bf16(pa0, PK(l0, h0), od, 0, 0, 0);
  od = __builtin_amdgcn_mfma_f32_32x32x16_bf16(pa1, PK(l1, h1), od, 0, 0, 0);
  od = __builtin_amdgcn_mfma_f32_32x32x16_bf16(pa2, PK(l2, h2), od, 0, 0, 0);
  od = __builtin_amdgcn_mfma_f32_32x32x16_bf16(pa3, PK(l3, h3), od, 0, 0, 0);
#undef PK
}
__device__ __forceinline__ void pv_d0(f32x16* o, int vb, bf16x8 pa0, bf16x8 pa1, bf16x8 pa2, bf16x8 pa3) {
  pv_one<0>(o[0], vb, pa0, pa1, pa2, pa3); pv_one<1>(o[1], vb, pa0, pa1, pa2, pa3); pv_one<2>(o[2], vb, pa0, pa1, pa2, pa3); pv_one<3>(o[3], vb, pa0, pa1, pa2, pa3);
}
__device__ __forceinline__ void rope_pair(bf16x8& x1, bf16x8& x2, const float* cs, int i0) {
  const f32x4 c0 = *(const f32x4*)(cs + i0), c1 = *(const f32x4*)(cs + i0 + 4), s0 = *(const f32x4*)(cs + 32 + i0), s1 = *(const f32x4*)(cs + 32 + i0 + 4);
  const float c[8] = {c0[0], c0[1], c0[2], c0[3], c1[0], c1[1], c1[2], c1[3]}, s[8] = {s0[0], s0[1], s0[2], s0[3], s1[0], s1[1], s1[2], s1[3]};
  u32x4 a = *reinterpret_cast<u32x4*>(&x1), b = *reinterpret_cast<u32x4*>(&x2), oa, ob;
#pragma unroll
  for (int w = 0; w < 4; ++w) {
    const float a0 = bf_lo(a[w]), a1 = bf_hi(a[w]), b0 = bf_lo(b[w]), b1 = bf_hi(b[w]);
    oa[w] = cvtpk(a0 * c[2 * w] - b0 * s[2 * w], a1 * c[2 * w + 1] - b1 * s[2 * w + 1]);
    ob[w] = cvtpk(b0 * c[2 * w] + a0 * s[2 * w], b1 * c[2 * w + 1] + a1 * s[2 * w + 1]); }
  x1 = *reinterpret_cast<bf16x8*>(&oa); x2 = *reinterpret_cast<bf16x8*>(&ob);
}
__device__ __forceinline__ void attn_unit(const unsigned short* __restrict__ Q, const unsigned short* __restrict__ Kn, const unsigned short* __restrict__ Kr, const unsigned short* __restrict__ V,
                                          const float* __restrict__ cs, unsigned short* __restrict__ O, int b, int h, int qb, char* lds) {
  int tid_ = threadIdx.x; asm volatile("" : "+v"(tid_));
  const int tid = tid_, wid = __builtin_amdgcn_readfirstlane(tid >> 6), lane = tid & 63, r32 = lane & 31, hi = lane >> 5;
  const long rowbase = (long)b * 2048; const int q0 = qb * 256;
  char* V_lds = lds + OFF_V; char* Kn_lds = lds + OFF_KN; char* Kr_lds = lds + OFF_KR;
  float* ws = (float*)(lds + OFF_WS) + wid * 64; float* li_l = ws; float* al_l = ws + 32;
  float m_reg = -1e30f, l_reg = 0; f32x16 o[4] = {}; bf16x8 qr[12];
  const long qrow = rowbase + q0 + wid * 32 + r32;
  const unsigned short* Qw = Q + qrow * 1536 + h * 192 + hi * 8;
#pragma unroll
  for (int d0 = 0; d0 < 12; ++d0) qr[d0] = *reinterpret_cast<const bf16x8*>(Qw + d0 * 16);
  rope_pair(qr[8], qr[10], cs + qrow * 64, hi * 8);
  rope_pair(qr[9], qr[11], cs + qrow * 64, 16 + hi * 8);
  const int sr = tid >> 4, sc = (tid & 15) * 8, vst0 = v_st(sr, sc), vst1 = v_st(32 + sr, sc);
  const int rr_ = tid >> 3, rc_ = (tid & 7) * 8;
  const int vb0 = (int)(uintptr_t)V_lds + v_rd_base(lane);
  const unsigned short* Knh = Kn + rowbase * 1024 + h * 128; const unsigned short* Vh = V + rowbase * 1024 + h * 128; const unsigned short* Krb = Kr + rowbase * 64;
  bf16x8 vs0, vs1, ks0, ks1, kr0;
#define SLOAD(k0) do { vs0 = *reinterpret_cast<const bf16x8*>(&Vh[(long)((k0) + sr) * 1024 + sc]); vs1 = *reinterpret_cast<const bf16x8*>(&Vh[(long)((k0) + 32 + sr) * 1024 + sc]); \
    ks0 = *reinterpret_cast<const bf16x8*>(&Knh[(long)((k0) + sr) * 1024 + sc]); ks1 = *reinterpret_cast<const bf16x8*>(&Knh[(long)((k0) + 32 + sr) * 1024 + sc]); \
    kr0 = *reinterpret_cast<const bf16x8*>(&Krb[(long)((k0) + rr_) * 64 + rc_]); } while (0)
#define SWRITE(bb) do { *(bf16x8*)(V_lds + (bb) * SHM_V + vst0) = vs0; *(bf16x8*)(V_lds + (bb) * SHM_V + vst1) = vs1; \
    *(bf16x8*)(Kn_lds + (bb) * SHM_KN + KSWZ(sr, sc * 2)) = ks0; *(bf16x8*)(Kn_lds + (bb) * SHM_KN + KSWZ(32 + sr, sc * 2)) = ks1; \
    *(bf16x8*)(Kr_lds + (bb) * SHM_KR + KRSWZ(rr_, rc_ * 2)) = kr0; } while (0)
  const int NT = 4 * (qb + 1);
  const int myNT = 4 * qb + (wid >> 1) + 1;
  SLOAD(0); SWRITE(0);
  for (int j = 0; j < NT; ++j) {
    __syncthreads();
    if (j + 1 < NT) SLOAD((j + 1) * 64);
    if (j < myNT) {
      f32x16 p0, p1; float alpha; bf16x8 pa0, pa1, pa2, pa3;
      qkt(p0, p1, Kn_lds + (j & 1) * SHM_KN, Kr_lds + (j & 1) * SHM_KR, qr, r32, hi);
      partialSM(p0, p1, m_reg, alpha);
      if (__any(alpha < 1.f)) { if (hi == 0) al_l[r32] = alpha; asm volatile("s_waitcnt lgkmcnt(0)" ::: "memory");
#pragma unroll
        for (int d = 0; d < 4; ++d)
#pragma unroll
          for (int r = 0; r < 16; ++r) o[d][r] *= al_l[crow(r, hi)]; }
      finishSM(p0, p1, alpha, l_reg, pa0, pa1, pa2, pa3); SBAR();
      pv_d0(o, vb0 + (j & 1) * SHM_V, pa0, pa1, pa2, pa3);
    }
    if (j + 1 < NT) SWRITE((j + 1) & 1);
  }
  if (hi == 0) li_l[r32] = l_reg; asm volatile("s_waitcnt lgkmcnt(0)" ::: "memory");
  float rli[16];
#pragma unroll
  for (int r = 0; r < 16; ++r) rli[r] = __builtin_amdgcn_rcpf(li_l[crow(r, hi)]);
  unsigned short* Ow = O + (rowbase + q0 + wid * 32) * 1024 + h * 128;
#pragma unroll
  for (int r = 0; r < 16; ++r) { const int orow = crow(r, hi);
#pragma unroll
    for (int d0 = 0; d0 < 4; ++d0) { const unsigned w = cvtpk(o[d0][r] * rli[r], 0.f); Ow[(long)orow * 1024 + d0 * 32 + r32] = (unsigned short)(w & 0xffffu); } }
  __syncthreads();
#undef SLOAD
#undef SWRITE
}
#undef SBAR
}

namespace cg = cooperative_groups;
#ifndef PROBE_ATT
#define PROBE_ATT 1
#endif
#ifndef PROBE_SYNC
#define PROBE_SYNC 0
#endif
#ifndef PROBE_PRO
#define PROBE_PRO 1
#endif
#ifndef PROBE_ELT
#define PROBE_ELT 1
#endif
#define LAS __attribute__((address_space(3)))
typedef unsigned short bf16;
typedef float f32x4 __attribute__((ext_vector_type(4)));
typedef float f32x2 __attribute__((ext_vector_type(2)));
typedef unsigned v4u __attribute__((ext_vector_type(4)));
typedef unsigned v2u __attribute__((ext_vector_type(2)));
constexpr int NWAVES = 8, NTHR = 512;
constexpr int M = 16384, D = 1024, SEQ = 2048, DFF = 2816, NUP = 2 * DFF, NSC = 3 * D, NCOMB = 768, NKV = 2048, NQ = 1536, KVL = 256, QL = 384;
constexpr size_t MiB = 1u << 20;
constexpr size_t WS_SSQ = 0;
constexpr size_t WS_CS = 1 * MiB;
constexpr size_t WS_WIN = 5 * MiB;
constexpr size_t WS_WOUT = 11 * MiB;
constexpr size_t WS_WUP = 13 * MiB;
constexpr size_t WS_WDN = 24 * MiB;
constexpr size_t WS_WCOMB = 30 * MiB;
constexpr size_t WS_WUKV = 32 * MiB;
constexpr size_t WS_WUQ = 33 * MiB;
constexpr size_t WS_WO = 35 * MiB;
constexpr size_t WS_HB = 37 * MiB;
constexpr size_t WS_BIG = 69 * MiB;
constexpr size_t WS_BAR = WS_BIG + 176 * MiB;
constexpr size_t WS_END = WS_BAR + 1 * MiB;
constexpr size_t HB_CKV = WS_HB, HB_CQ = WS_HB + 8 * MiB, HB_KR = WS_HB + 20 * MiB;
constexpr size_t BIG_G = WS_BIG, BIG_V = WS_BIG + 88 * MiB, BIG_HALO = WS_BIG, BIG_HEADG = WS_BIG + 2 * MiB, BIG_HEADV = WS_BIG + 4 * MiB;
constexpr size_t BIG_SC = WS_BIG, BIG_MIX = WS_BIG + 96 * MiB;
constexpr size_t BIG_COMB = WS_BIG, BIG_O = WS_BIG, BIG_Q = WS_BIG + 48 * MiB, BIG_KN = WS_BIG + 96 * MiB, BIG_VV = WS_BIG + 128 * MiB;
constexpr int RING_BYTES = 131072, LDSX_OFF = RING_BYTES, LDS_BYTES = RING_BYTES + 8192;

#define RLX_AGENT __ATOMIC_RELAXED, __HIP_MEMORY_SCOPE_AGENT
#define XB_TMO      128
#define XB_XCNT(j)  (256  + 64 * (j))
#define XB_XSUB(j)  (1280 + 64 * (j))
#define XB_XGEN(j)  (2304 + 64 * (j))
#define XB_TOP      3328
#define XB_TOPGEN   3392
#define XCD_BAR_WORDS 3456
#define XB_SPIN_CAP (1u << 18)

__device__ __forceinline__ unsigned xb_ld(unsigned* p)              { return __hip_atomic_load(p, __ATOMIC_RELAXED, __HIP_MEMORY_SCOPE_AGENT); }
__device__ __forceinline__ unsigned xb_add(unsigned* p, unsigned v) { return __hip_atomic_fetch_add(p, v, __ATOMIC_RELAXED, __HIP_MEMORY_SCOPE_AGENT); }
__device__ __forceinline__ unsigned xb_xcc_id() { return (unsigned)__builtin_amdgcn_s_getreg((3 << 11) | 20) & 0xFu; }
#define XB_SPIN(cond, bar) do { unsigned _sp = 0; while (cond) { __builtin_amdgcn_s_sleep(1); \
    if ((++_sp & 255u) == 0u) { if (xb_ld(&(bar)[XB_TMO])) break; if (_sp > XB_SPIN_CAP) { atomicAdd(&(bar)[XB_TMO], 1u); break; } } } } while (0)

struct XcdBarrier {
    unsigned* bar; unsigned x;
    volatile LAS unsigned* st;
};

__device__ __forceinline__ XcdBarrier xcd_barrier_post(unsigned* bar, volatile LAS unsigned* st) {
    XcdBarrier b; b.bar = bar; b.x = xb_xcc_id(); b.st = st;
    if (threadIdx.x == 0) (void)xb_add(&bar[XB_XCNT(b.x)], 1u);
    return b;
}
__device__ __forceinline__ void xcd_barrier_complete(unsigned* bar, unsigned x, unsigned& nloc, unsigned& nx) {
    const unsigned G = gridDim.x * gridDim.y * gridDim.z;
    unsigned sum, cnt, mine, sp = 0u;
    for (;;) {
        sum = 0u; cnt = 0u; mine = 0u;
#pragma unroll
        for (unsigned j = 0; j < 16; ++j) { const unsigned c = xb_ld(&bar[XB_XCNT(j)]); sum += c; cnt += (c > 0u) ? 1u : 0u; mine = (j == x) ? c : mine; }
        if (sum == G) break;
        __builtin_amdgcn_s_sleep(1);
        if ((++sp & 255u) == 0u) { if (xb_ld(&bar[XB_TMO])) break; if (sp > XB_SPIN_CAP) { atomicAdd(&bar[XB_TMO], 1u); break; } }
    }
    nloc = mine > 0u ? mine : 1u; nx = cnt > 0u ? cnt : 1u;
}

__device__ __forceinline__ void xcd_barrier(const XcdBarrier& b) {
    asm volatile("s_waitcnt vmcnt(0)" ::: "memory");
    __syncthreads();
    if (threadIdx.x == 0) {
        unsigned* bar = b.bar;
        __builtin_amdgcn_s_waitcnt(0);
        unsigned nloc = b.st[0], nx = b.st[1];
        if (nloc == 0u) { xcd_barrier_complete(bar, b.x, nloc, nx); b.st[0] = nloc; b.st[1] = nx; }
        const unsigned old = xb_add(&bar[XB_XSUB(b.x)], 1u);
        const unsigned gen = old / nloc;
        if (old + 1u == (gen + 1u) * nloc) {
            __builtin_amdgcn_fence(__ATOMIC_RELEASE, "agent");
            asm volatile("s_waitcnt vmcnt(0)" ::: "memory");
            const unsigned og = xb_add(&bar[XB_TOP], 1u);
            const unsigned tg = og / nx;
            if (og + 1u == (tg + 1u) * nx) xb_add(&bar[XB_TOPGEN], 1u);
            else XB_SPIN(xb_ld(&bar[XB_TOPGEN]) == tg, bar);
            __builtin_amdgcn_fence(__ATOMIC_ACQUIRE, "agent");
            xb_add(&bar[XB_XGEN(b.x)], 1u);
            asm volatile("s_waitcnt vmcnt(0)" ::: "memory");
        } else {
            XB_SPIN(xb_ld(&bar[XB_XGEN(b.x)]) == gen, bar);
            __builtin_amdgcn_fence(__ATOMIC_ACQUIRE, "agent");
            asm volatile("s_waitcnt vmcnt(0)" ::: "memory");
        }
    }
    __syncthreads();
}

struct Args { const float* in[22]; const int* pos; float* out; unsigned char* ws; };

__device__ __forceinline__ unsigned f2bf(float f) { unsigned u = __builtin_bit_cast(unsigned, f); return (u + 0x7fffu + ((u >> 16) & 1u)) >> 16; }
__device__ __forceinline__ unsigned pk2(float lo, float hi) { return f2bf(lo) | (f2bf(hi) << 16); }
__device__ __forceinline__ float bflo(unsigned w) { return __uint_as_float(w << 16); }
__device__ __forceinline__ float bfhi(unsigned w) { return __uint_as_float(w & 0xffff0000u); }
__device__ __forceinline__ float wave_sum(float v) {
#pragma unroll
    for (int o = 1; o < 64; o <<= 1) v += __shfl_xor(v, o);
    return v;
}
__device__ __forceinline__ void transpose_item(const float* W, int K, int N, bf16* WT, int row_off, const float* gain, LAS float* scr, int item, int lane, bool upmap = false) {
    const int nblk = N / 32, kb = item / nblk, nb = item % nblk, k0 = 64 * kb, n0 = 32 * nb;
    float v[32];
#pragma unroll
    for (int i = 0; i < 32; ++i) { const int kk = 2 * i + (lane >> 5); v[i] = W[(size_t)(k0 + kk) * N + n0 + (lane & 31)]; }
#pragma unroll
    for (int i = 0; i < 32; ++i) { const int kk = 2 * i + (lane >> 5); const float g = gain ? gain[k0 + kk] : 1.f; scr[kk * 33 + (lane & 31)] = v[i] * g; }
    asm volatile("s_waitcnt lgkmcnt(0)" ::: "memory");
    const int c = lane & 7;
    const int r0 = upmap ? 256 * ((n0 % 2816) / 128) + 128 * (n0 / 2816) + (n0 % 128) : n0;
#pragma unroll
    for (int j = 0; j < 4; ++j) { const int n = (lane >> 3) + 8 * j; const LAS float* s = scr + (8 * c) * 33 + n;
        v4u o; o.x = pk2(s[0 * 33], s[1 * 33]); o.y = pk2(s[2 * 33], s[3 * 33]); o.z = pk2(s[4 * 33], s[5 * 33]); o.w = pk2(s[6 * 33], s[7 * 33]);
        *(v4u*)(WT + (size_t)(row_off + r0 + n) * K + k0 + 8 * c) = o; }
    asm volatile("s_waitcnt lgkmcnt(0)" ::: "memory");
}
struct TJob { const float* W; int K, N; bf16* WT; int row_off; const float* gain; };
__device__ __forceinline__ int tjob_items(const TJob& j) { return (j.K / 64) * (j.N / 32); }

__device__ __forceinline__ void sincos_red(double r, float& sn, float& cs_) {
    const double y = 0.5 * r, y2 = y * y;
    double s = -7.6471637318198164759e-13;
    s = s * y2 + 1.6059043836821614599e-10;
    s = s * y2 - 2.5052108385441718775e-8;
    s = s * y2 + 2.7557319223985890653e-6;
    s = s * y2 - 1.9841269841269841270e-4;
    s = s * y2 + 8.3333333333333333333e-3;
    s = s * y2 - 1.6666666666666666667e-1;
    s = s * y2 + 1.0; s *= y;
    double c = 4.7794773323873852974e-14;
    c = c * y2 - 1.1470745597729724714e-11;
    c = c * y2 + 2.0876756987868098979e-9;
    c = c * y2 - 2.7557319223985890653e-7;
    c = c * y2 + 2.4801587301587301587e-5;
    c = c * y2 - 1.3888888888888888889e-3;
    c = c * y2 + 4.1666666666666666667e-2;
    c = c * y2 - 0.5;
    c = c * y2 + 1.0;
    sn = (float)(2.0 * s * c); cs_ = (float)(1.0 - 2.0 * s * s);
}

__global__ void __launch_bounds__(NTHR) fwd_megakernel(Args args) {
    extern __shared__ __attribute__((aligned(16))) unsigned char lds[];
    cg::grid_group grid = cg::this_grid();
    const int G = gridDim.x, bx = blockIdx.x;
#define PHASE_IDS int tid_ = threadIdx.x; asm volatile("" : "+v"(tid_)); const int tid = tid_, lane = tid & 63, wave = __builtin_amdgcn_readfirstlane(tid >> 6); \
    const int vcu = (G % 8 == 0) ? (bx % 8) * (G / 8) + bx / 8 : bx; const int gw = vcu * NWAVES + wave, NGW = G * NWAVES; const int gt = bx * NTHR + tid, NGT = G * NTHR; \
    (void)lane; (void)gw; (void)NGW; (void)gt; (void)NGT; (void)vcu;
    unsigned char* ws = args.ws;
    LAS unsigned char* ldsl = (LAS unsigned char*)lds;
    const float* x = args.in[0];
    const float *attn_norm = args.in[2], *ffn_norm = args.in[3], *final_norm = args.in[4], *sc_w_in = args.in[5], *sc_conv_w = args.in[6], *sc_w_out = args.in[7];
    const float *kv_in_norm = args.in[8], *w_dkv = args.in[9], *kv_latent_norm = args.in[10], *w_kr = args.in[11], *w_uk = args.in[12], *w_uv = args.in[13];
    const float *w_dq = args.in[14], *q_latent_norm = args.in[15], *w_uq = args.in[16], *w_o = args.in[17];
    const float *ffn_w_up = args.in[18], *ffn_conv_w = args.in[19], *ffn_conv_b = args.in[20], *ffn_w_down = args.in[21];
    float* out = args.out;
    float* ssq = (float*)(ws + WS_SSQ); float* cst = (float*)(ws + WS_CS);
    bf16 *Win = (bf16*)(ws + WS_WIN), *Wout = (bf16*)(ws + WS_WOUT), *Wup = (bf16*)(ws + WS_WUP), *Wdn = (bf16*)(ws + WS_WDN), *Wcomb = (bf16*)(ws + WS_WCOMB),
         *Wukv = (bf16*)(ws + WS_WUKV), *Wuq = (bf16*)(ws + WS_WUQ), *Wo = (bf16*)(ws + WS_WO), *hb = (bf16*)(ws + WS_HB);

    for (int u = threadIdx.x; u < (LDS_BYTES - LDSX_OFF) / 4; u += NTHR) ((LAS unsigned*)(ldsl + LDSX_OFF))[u] = 0u;
    if (bx == 0) for (int u = threadIdx.x; u < XCD_BAR_WORDS; u += NTHR) ((unsigned*)(ws + WS_BAR))[u] = 0u;
    __syncthreads();
    for (int rep_ = 0; rep_ < PROBE_PRO; ++rep_) {
        PHASE_IDS
        LAS float* scr = (LAS float*)(ldsl + wave * 16384);
        int base = 0;
#define TJ(W_, K_, N_, WT_, RO_, G_, UM_) { const int n_ = ((K_) / 64) * ((N_) / 32); int it = gw; if (it < base) it += ((base - it + NGW - 1) / NGW) * NGW; \
            for (; it < base + n_; it += NGW) transpose_item(W_, K_, N_, WT_, RO_, G_, scr, it - base, lane, UM_); base += n_; }
        TJ(sc_w_in, D, NSC, Win, 0, attn_norm, false) TJ(sc_w_out, D, D, Wout, 0, nullptr, false) TJ(ffn_w_up, D, NUP, Wup, 0, ffn_norm, true) TJ(ffn_w_down, DFF, D, Wdn, 0, nullptr, false)
        TJ(w_dkv, D, KVL, Wcomb, 0, kv_in_norm, false) TJ(w_kr, D, 64, Wcomb, 256, kv_in_norm, false) TJ(w_dq, D, QL, Wcomb, 320, attn_norm + D, false)
        TJ(w_uk, KVL, D, Wukv, 0, nullptr, false) TJ(w_uv, KVL, D, Wukv, 1024, nullptr, false) TJ(w_uq, QL, NQ, Wuq, 0, nullptr, false) TJ(w_o, D, D, Wo, 0, nullptr, false)
        for (int i = gt; i < 64 * D / 8; i += NGT) *(v4u*)(Wcomb + (size_t)704 * D + (size_t)i * 8) = (v4u){0u, 0u, 0u, 0u};
        for (int m = gw; m < M; m += NGW) {
            const f32x4* xr = (const f32x4*)(x + (size_t)m * D) + lane; unsigned long long* o8 = (unsigned long long*)(hb + (size_t)m * D) + lane; float s = 0.f;
#pragma unroll
            for (int j = 0; j < 4; ++j) { const f32x4 v = xr[64 * j]; s += (v[0] * v[0] + v[1] * v[1]) + (v[2] * v[2] + v[3] * v[3]);
                o8[64 * j] = (unsigned long long)pk2(v[0], v[1]) | ((unsigned long long)pk2(v[2], v[3]) << 32); }
            s = wave_sum(s);
            if (lane < 16) ssq[(size_t)m * 16 + lane] = lane == 0 ? s : 0.f;
        }
        for (int i = gt; i < M * 32; i += NGT) { const int row = i >> 5, f = i & 31;
            double inv = 1.0; for (int k = 0; k < f; ++k) inv *= 0.74989420933245582730;
            const double ang = (double)args.pos[row] * inv;
            const double kq = __builtin_rint(ang * 0.15915494309189535);
            double r = ang - kq * 6.283185307179586; r -= kq * 2.4492935982947064e-16;
            float sn, cs_; sincos_red(r, sn, cs_);
            cst[(size_t)row * 64 + f] = cs_; cst[(size_t)row * 64 + 32 + f] = sn; }
    }
    grid.sync();
    const XcdBarrier xbar = xcd_barrier_post((unsigned*)(ws + WS_BAR), (volatile LAS unsigned*)(ldsl + LDSX_OFF));
    for (int rep_ = 0; rep_ < PROBE_SYNC; ++rep_) xcd_barrier(xbar);

#pragma nounroll
    for (int layer = 0; layer < 2; ++layer) {
        if (layer == 0) {
            { pg8::Gemm g{hb, Win, M, NSC, D}; pg8::StaticOrder S; S.init(M, NSC, G, bx);
              pg8::EpiBf16S E{(bf16*)(ws + BIG_SC), nullptr, 1 << 30, NSC, ssq};
              pg8::gemm_phase<pg8::EpiBf16S, pg8::StaticOrder, true, true>(ldsl, g, S, E); }
            xcd_barrier(xbar);
            for (int rep_ = 0; rep_ < PROBE_ELT; ++rep_) { PHASE_IDS const bf16* sc = (const bf16*)(ws + BIG_SC); bf16* mix = (bf16*)(ws + BIG_MIX);
              for (int it = gt; it < (M / 16) * (D / 8); it += NGT) { const int tb = it / (D / 8), cgp = it % (D / 8), t0 = tb * 16, c0 = cgp * 8;
                float w0[8], w1[8], w2[8], p1[8], p2[8];
#pragma unroll
                for (int e = 0; e < 8; ++e) { w0[e] = sc_conv_w[c0 + e]; w1[e] = sc_conv_w[D + c0 + e]; w2[e] = sc_conv_w[2 * D + c0 + e]; p1[e] = 0.f; p2[e] = 0.f; }
                if (t0 % SEQ != 0) {
                    const v4u c2 = *(const v4u*)(sc + (size_t)(t0 - 2) * NSC + D + c0), u2 = *(const v4u*)(sc + (size_t)(t0 - 2) * NSC + 2 * D + c0);
                    const v4u c1 = *(const v4u*)(sc + (size_t)(t0 - 1) * NSC + D + c0), u1 = *(const v4u*)(sc + (size_t)(t0 - 1) * NSC + 2 * D + c0);
#pragma unroll
                    for (int w = 0; w < 4; ++w) { p2[2 * w] = bflo(c2[w]) * bflo(u2[w]); p2[2 * w + 1] = bfhi(c2[w]) * bfhi(u2[w]); p1[2 * w] = bflo(c1[w]) * bflo(u1[w]); p1[2 * w + 1] = bfhi(c1[w]) * bfhi(u1[w]); }
                }
#pragma unroll 4
                for (int t = 0; t < 16; ++t) { const size_t ro = (size_t)(t0 + t) * NSC + c0;
                    const v4u bb = *(const v4u*)(sc + ro), cc = *(const v4u*)(sc + ro + D), uu = *(const v4u*)(sc + ro + 2 * D); float cu[8], y[8];
#pragma unroll
                    for (int w = 0; w < 4; ++w) { cu[2 * w] = bflo(cc[w]) * bflo(uu[w]); cu[2 * w + 1] = bfhi(cc[w]) * bfhi(uu[w]); }
#pragma unroll
                    for (int e = 0; e < 8; ++e) { y[e] = w0[e] * p2[e] + w1[e] * p1[e] + w2[e] * cu[e]; p2[e] = p1[e]; p1[e] = cu[e]; }
                    v4u o;
#pragma unroll
                    for (int w = 0; w < 4; ++w) o[w] = pk2(bflo(bb[w]) * y[2 * w], bfhi(bb[w]) * y[2 * w + 1]);
                    *(v4u*)(mix + (size_t)(t0 + t) * D + c0) = o; } } }
            xcd_barrier(xbar);
            { pg8::Gemm g{(const bf16*)(ws + BIG_MIX), Wout, M, D, D}; pg8::StaticOrder S; S.init(M, D, G, bx);
              pg8::EpiRes E{x, out, hb, ssq, D};
              pg8::gemm_phase<pg8::EpiRes, pg8::StaticOrder, true, true>(ldsl, g, S, E); }
            xcd_barrier(xbar);
        } else {
            { pg8::Gemm g{hb, Wcomb, M, NCOMB, D}; pg8::StaticOrder S; S.init(M, NCOMB, G, bx);
              pg8::EpiF32S E{(float*)(ws + BIG_COMB), NCOMB, ssq};
              pg8::gemm_phase<pg8::EpiF32S, pg8::StaticOrder, true, true>(ldsl, g, S, E); }
            xcd_barrier(xbar);
            { PHASE_IDS const float* comb = (const float*)(ws + BIG_COMB); bf16* ckv = (bf16*)(ws + HB_CKV); bf16* cq = (bf16*)(ws + HB_CQ); bf16* kr = (bf16*)(ws + HB_KR);
              for (int m = gw; m < M; m += NGW) { const float* row = comb + (size_t)m * NCOMB;
                { const f32x4 v = *((const f32x4*)row + lane); const float s = wave_sum((v[0] * v[0] + v[1] * v[1]) + (v[2] * v[2] + v[3] * v[3]));
                  const float r = __builtin_amdgcn_rsqf(s * (1.f / KVL) + 1e-6f); const f32x4 gn = *((const f32x4*)kv_latent_norm + lane);
                  v2u o; o.x = pk2(v[0] * r * gn[0], v[1] * r * gn[1]); o.y = pk2(v[2] * r * gn[2], v[3] * r * gn[3]); *((v2u*)(ckv + (size_t)m * KVL) + lane) = o; }
                { const int i = lane & 31; const float x1 = row[256 + i], x2 = row[288 + i], c = cst[(size_t)m * 64 + i], s = cst[(size_t)m * 64 + 32 + i];
                  const float o = lane < 32 ? x1 * c - x2 * s : x2 * c + x1 * s; kr[(size_t)m * 64 + lane] = (bf16)f2bf(o); }
                { f32x2 v[3]; float s = 0.f;
#pragma unroll
                  for (int j = 0; j < 3; ++j) { v[j] = *((const f32x2*)(row + 320 + j * 128) + lane); s += v[j][0] * v[j][0] + v[j][1] * v[j][1]; }
                  s = wave_sum(s); const float r = __builtin_amdgcn_rsqf(s * (1.f / QL) + 1e-6f);
#pragma unroll
                  for (int j = 0; j < 3; ++j) { const f32x2 gn = *((const f32x2*)(q_latent_norm + j * 128) + lane);
                    *((unsigned*)(cq + (size_t)m * QL + j * 128) + lane) = pk2(v[j][0] * r * gn[0], v[j][1] * r * gn[1]); } } }
              LAS float* scr = (LAS float*)(ldsl + wave * 16384);
              const TJob j0{ffn_w_up + (size_t)D * NUP, D, NUP, Wup, 0, ffn_norm + D}, j1{ffn_w_down + (size_t)DFF * D, DFF, D, Wdn, 0, nullptr};
              const int n0 = tjob_items(j0), n1 = tjob_items(j1);
              for (int it = gw; it < n0 + n1; it += NGW) { if (it < n0) transpose_item(j0.W, j0.K, j0.N, j0.WT, 0, j0.gain, scr, it, lane, true); else transpose_item(j1.W, j1.K, j1.N, j1.WT, 0, nullptr, scr, it - n0, lane); } }
            xcd_barrier(xbar);
            { pg8::Gemm g{(const bf16*)(ws + HB_CKV), Wukv, M, NKV, KVL}; pg8::StaticOrder S; S.init(M, NKV, G, bx);
              pg8::EpiBf16S E{(bf16*)(ws + BIG_KN), (bf16*)(ws + BIG_VV), 1024, 1024, nullptr};
              pg8::gemm_phase<pg8::EpiBf16S, pg8::StaticOrder, true, true>(ldsl, g, S, E); }
            { pg8::Gemm g{(const bf16*)(ws + HB_CQ), Wuq, M, NQ, QL}; pg8::StaticOrder S; S.init(M, NQ, G, bx);
              pg8::EpiBf16S E{(bf16*)(ws + BIG_Q), nullptr, 1 << 30, NQ, nullptr};
              pg8::gemm_phase<pg8::EpiBf16S, pg8::StaticOrder, true, true>(ldsl, g, S, E); }
            xcd_barrier(xbar);
            for (int rep_ = 0; rep_ < PROBE_ATT; ++rep_) { PHASE_IDS for (int p = vcu; p < 256; p += G) { const int bh = p >> 2, s4 = p & 3;
                att::attn_unit((const bf16*)(ws + BIG_Q), (const bf16*)(ws + BIG_KN), (const bf16*)(ws + HB_KR), (const bf16*)(ws + BIG_VV), cst, (bf16*)(ws + BIG_O), bh >> 3, bh & 7, 7 - s4, (char*)lds);
                att::attn_unit((const bf16*)(ws + BIG_Q), (const bf16*)(ws + BIG_KN), (const bf16*)(ws + HB_KR), (const bf16*)(ws + BIG_VV), cst, (bf16*)(ws + BIG_O), bh >> 3, bh & 7, s4, (char*)lds); } }
            xcd_barrier(xbar);
            { pg8::Gemm g{(const bf16*)(ws + BIG_O), Wo, M, D, D}; pg8::StaticOrder S; S.init(M, D, G, bx);
              pg8::EpiRes E{out, out, hb, ssq, D};
              pg8::gemm_phase<pg8::EpiRes, pg8::StaticOrder, true, true>(ldsl, g, S, E); }
            xcd_barrier(xbar);
        }
        { pg8::Gemm g{hb, Wup, M, NUP, D}; pg8::StaticOrder S; S.init(M, NUP, G, bx);
          pg8::EpiGate E{(bf16*)(ws + BIG_V), ssq, ffn_conv_w + (size_t)layer * 3 * DFF, ffn_conv_b + (size_t)layer * DFF, (float*)(ws + BIG_HALO), (float*)(ws + BIG_HEADG), (float*)(ws + BIG_HEADV), (LAS float*)(ldsl + LDSX_OFF + 256)};
          pg8::gemm_phase<pg8::EpiGate, pg8::StaticOrder, true, true>(ldsl, g, S, E); }
        xcd_barrier(xbar);
        { PHASE_IDS const float* cw = ffn_conv_w + (size_t)layer * 3 * DFF; const float* cb = ffn_conv_b + (size_t)layer * DFF;
          const float* halo = (const float*)(ws + BIG_HALO); const float* hg = (const float*)(ws + BIG_HEADG); const float* hv = (const float*)(ws + BIG_HEADV); bf16* act = (bf16*)(ws + BIG_V);
          for (int it = gt; it < 64 * DFF; it += NGT) { const int pm = it / DFF, ch = it % DFF; if ((pm & 7) == 0) continue;
            const float gm2 = halo[(size_t)(pm - 1) * 2 * DFF + ch], gm1 = halo[(size_t)((pm - 1) * 2 + 1) * DFF + ch], g0 = hg[(size_t)pm * 2 * DFF + ch], g1 = hg[(size_t)(pm * 2 + 1) * DFF + ch];
            const float v0 = hv[(size_t)pm * 2 * DFF + ch], v1 = hv[(size_t)(pm * 2 + 1) * DFF + ch], w0 = cw[ch], w1 = cw[DFF + ch], w2 = cw[2 * DFF + ch], b = cb[ch];
            const float z0 = w0 * gm2 + w1 * gm1 + w2 * g0 + b, z1 = w0 * gm1 + w1 * g0 + w2 * g1 + b;
            act[(size_t)(pm * 256) * DFF + ch] = (bf16)f2bf(z0 * __builtin_amdgcn_rcpf(1.f + __expf(-z0)) * v0);
            act[(size_t)(pm * 256 + 1) * DFF + ch] = (bf16)f2bf(z1 * __builtin_amdgcn_rcpf(1.f + __expf(-z1)) * v1); } }
        xcd_barrier(xbar);
        { pg8::Gemm g{(const bf16*)(ws + BIG_V), Wdn, M, D, DFF}; pg8::StaticOrder S; S.init(M, D, G, bx);
          pg8::EpiRes E{out, out, hb, ssq, D};
          pg8::gemm_phase<pg8::EpiRes, pg8::StaticOrder, true, true>(ldsl, g, S, E); }
        xcd_barrier(xbar);
    }
    { PHASE_IDS
    for (int m = gw; m < M; m += NGW) { f32x4* xr = (f32x4*)(out + (size_t)m * D) + lane; f32x4 v[4]; float s = 0.f;
#pragma unroll
        for (int j = 0; j < 4; ++j) { v[j] = xr[64 * j]; s += (v[j][0] * v[j][0] + v[j][1] * v[j][1]) + (v[j][2] * v[j][2] + v[j][3] * v[j][3]); }
        const float r = __builtin_amdgcn_rsqf(wave_sum(s) * (1.f / D) + 1e-6f);
#pragma unroll
        for (int j = 0; j < 4; ++j) { const f32x4 gn = *((const f32x4*)final_norm + lane + 64 * j); xr[64 * j] = v[j] * r * gn; } } }
}

extern "C" void kernel_launch(void* const* d_in, const int* in_sizes, int n_in, void* d_out, int out_size, void* d_ws, size_t ws_size, hipStream_t stream) {
    static int grid_blocks = 0;
    if (grid_blocks == 0) {
        if (n_in != 22 || out_size != M * D || ws_size < WS_END) { fprintf(stderr, "kernel_launch: unexpected shapes: n_in %d out %d ws %zu (need %zu)\n", n_in, out_size, ws_size, (size_t)WS_END); grid_blocks = -1; return; }
        int dev = 0, cus = 0, per_cu = 0;
        hipGetDevice(&dev);
        hipDeviceGetAttribute(&cus, hipDeviceAttributeMultiprocessorCount, dev);
        if (hipFuncSetAttribute((const void*)fwd_megakernel, hipFuncAttributeMaxDynamicSharedMemorySize, LDS_BYTES) != hipSuccess) { fprintf(stderr, "kernel_launch: hipFuncSetAttribute failed\n"); grid_blocks = -1; return; }
        if (hipOccupancyMaxActiveBlocksPerMultiprocessor(&per_cu, (const void*)fwd_megakernel, NTHR, LDS_BYTES) != hipSuccess || per_cu < 1) { fprintf(stderr, "kernel_launch: occupancy query failed (%d)\n", per_cu); (void)hipGetLastError(); grid_blocks = -1; return; }
        grid_blocks = cus * per_cu;
    }
    if (grid_blocks < 0) return;
    Args a{};
    for (int i = 0; i < 22; ++i) a.in[i] = (const float*)d_in[i];
    a.pos = (const int*)d_in[1]; a.out = (float*)d_out; a.ws = (unsigned char*)d_ws;
    void* kargs[] = {&a};
    hipError_t e = hipLaunchCooperativeKernel((const void*)fwd_megakernel, dim3(grid_blocks), dim3(NTHR), kargs, LDS_BYTES, stream);
    if (e != hipSuccess) fprintf(stderr, "cooperative launch failed: %s (grid %d)\n", hipGetErrorString(e), grid_blocks);
}
```
